# Optimizing an MI355X kernel written in HIP

```python
import math
import jax, jax.numpy as jnp
from jax import lax
import numpy as np

D_MODEL = 1024
BATCH = 1
SEQ = 16384
DEPTH = 2
DEC_BATCH = 8
DEC_SEQ = 32
PAST_LEN = 2048

CHUNK = 64
CONV_W = 3
D_CONV = 1024
SSM_GROUP = 16
SSM_STATE = 64
D_SSM = 1024
SSM_GROUPS = D_SSM // SSM_GROUP
XA_HEADS = 4
XA_HEAD_DIM = 256
D_XA = XA_HEADS * XA_HEAD_DIM
N_MEM = 256
D_MIX = D_CONV + D_SSM + D_XA
D_IN = 4 * D_CONV + 2 * D_SSM + 2 * D_XA
SPLITS = (D_CONV, 2 * D_CONV, 3 * D_CONV, 4 * D_CONV,
          4 * D_CONV + D_SSM, 4 * D_CONV + 2 * D_SSM, 4 * D_CONV + 2 * D_SSM + D_XA)
EPS = 1e-6

kernel_name = "hybrid_conv_s5_memxattn_stream_step"


def rmsnorm(x, g):
    xf = x.astype(jnp.float32)
    y = xf * lax.rsqrt(jnp.mean(xf * xf, axis=-1, keepdims=True) + EPS)
    return (y * g.astype(jnp.float32)).astype(x.dtype)


def mem_kv(mem, g, w_kv):
    b, n, _ = mem.shape
    k, v = jnp.split(rmsnorm(mem, g) @ w_kv, 2, axis=-1)
    return (k.reshape(b, n, XA_HEADS, XA_HEAD_DIM), v.reshape(b, n, XA_HEADS, XA_HEAD_DIM))


def short_conv(u, buf, w, bias):
    t = u.shape[1]
    full = jnp.concatenate([buf.astype(u.dtype), u], axis=1)
    y = sum((full[:, j:j + t] * w[j] for j in range(CONV_W)), bias)
    return y, full[:, -(CONV_W - 1):]


def ssm_discretize(lam_re, lam_im, log_dt, b_re, b_im, c_re, c_im):
    f32 = jnp.float32
    lam = lax.complex(lam_re.astype(f32), lam_im.astype(f32))
    dt = jnp.exp(log_dt.astype(f32))[:, None]
    lam_bar = jnp.exp(lam * dt)
    b = lax.complex(b_re.astype(f32), b_im.astype(f32))
    b_bar = ((lam_bar - 1.0) / lam)[..., None] * b
    c = lax.complex(c_re.astype(f32), c_im.astype(f32))
    return lam_bar, b_bar, c


def _lin_comb(left, right):
    a_l, b_l = left
    a_r, b_r = right
    return a_l * a_r, a_r * b_l + b_r


def ssm_block(h0, u, lam_bar, b_bar, c):
    bu = jnp.einsum('gni,blgi->blgn', b_bar, u.astype(jnp.complex64))
    bu = bu.at[:, 0].add(lam_bar * h0)
    a = jnp.broadcast_to(lam_bar, bu.shape)
    _, h = lax.associative_scan(_lin_comb, (a, bu), axis=1)
    y = jnp.einsum('gin,blgn->blgi', c, h).real
    return h[:, -1], y


def ssm_scan(u, h0, lam_bar, b_bar, c):
    b, t, g, i = u.shape
    if t <= CHUNK:
        return ssm_block(h0, u, lam_bar, b_bar, c)
    nb = t // CHUNK
    ub = u.reshape(b, nb, CHUNK, g, i).transpose(1, 0, 2, 3, 4)
    h_last, yb = lax.scan(lambda h, ublk: ssm_block(h, ublk, lam_bar, b_bar, c), h0, ub)
    return h_last, yb.transpose(1, 0, 2, 3, 4).reshape(b, t, g, i)


def layer(x, conv_buf, h0, k, v, norm_g, w_in, conv_w, conv_b, lam_re, lam_im, log_dt,
          b_re, b_im, c_re, c_im, ssm_d, glu_w, glu_b, w_out):
    f32 = jnp.float32
    bsz, t, _ = x.shape
    h = rmsnorm(x, norm_g)
    z = h @ w_in
    cx, cb, cc, cg, su, sg, q, qg = jnp.split(z, SPLITS, axis=-1)
    conv_out, new_buf = short_conv(cc * cx, conv_buf, conv_w, conv_b)
    y_conv = cb * conv_out * jax.nn.silu(cg)
    lam_bar, b_bar, c = ssm_discretize(lam_re, lam_im, log_dt, b_re, b_im, c_re, c_im)
    uf = su.astype(f32)
    h_last, ys = ssm_scan(uf.reshape(bsz, t, SSM_GROUPS, SSM_GROUP), h0, lam_bar, b_bar, c)
    ys = jax.nn.gelu(ys.reshape(bsz, t, D_SSM) + ssm_d.astype(f32) * uf).astype(x.dtype)
    y_ssm = ys * jax.nn.sigmoid(ys @ glu_w + glu_b) * jax.nn.silu(sg)
    qh = q.reshape(bsz, t, XA_HEADS, XA_HEAD_DIM).astype(f32)
    s = jnp.einsum('bthd,bmhd->bhtm', qh, k.astype(f32)) * (XA_HEAD_DIM ** -0.5)
    p = jax.nn.softmax(s, axis=-1)
    o = jnp.einsum('bhtm,bmhd->bthd', p, v.astype(f32)).reshape(bsz, t, D_XA).astype(x.dtype)
    y_xa = o * jax.nn.silu(qg)
    out = jnp.concatenate([y_conv, y_ssm, y_xa], axis=-1) @ w_out
    return x + out, new_buf, h_last


def setup_inputs(seed: int = 0) -> dict:
    key = jax.random.key(seed)
    ks = jax.random.split(key, 32)
    nrm = lambda k, s: jax.random.normal(k, s, jnp.float32)
    lam_im = jnp.broadcast_to(jnp.pi * jnp.arange(SSM_STATE, dtype=jnp.float32), (DEPTH, SSM_GROUPS, SSM_STATE))
    return {
        "x_prompt": nrm(ks[0], (BATCH, SEQ, D_MODEL)),
        "x_sample": nrm(ks[1], (DEC_BATCH, DEC_SEQ, D_MODEL)),
        "mem_prompt": nrm(ks[2], (BATCH, N_MEM, D_MODEL)),
        "cache_conv": nrm(ks[3], (DEPTH, DEC_BATCH, CONV_W - 1, D_CONV)),
        "state_ssm_re": 0.3 * nrm(ks[4], (DEPTH, DEC_BATCH, SSM_GROUPS, SSM_STATE)),
        "state_ssm_im": 0.3 * nrm(ks[5], (DEPTH, DEC_BATCH, SSM_GROUPS, SSM_STATE)),
        "cache_mem_k": nrm(ks[6], (DEPTH, DEC_BATCH, N_MEM, XA_HEADS, XA_HEAD_DIM)),
        "cache_mem_v": nrm(ks[7], (DEPTH, DEC_BATCH, N_MEM, XA_HEADS, XA_HEAD_DIM)),
        "norm_g": 1.0 + 0.01 * nrm(ks[8], (DEPTH, D_MODEL)),
        "w_in": nrm(ks[9], (DEPTH, D_MODEL, D_IN)) * D_MODEL ** -0.5,
        "conv_w": nrm(ks[10], (DEPTH, CONV_W, D_CONV)) * CONV_W ** -0.5,
        "conv_b": 0.01 * nrm(ks[11], (DEPTH, D_CONV)),
        "ssm_lambda_re": -0.5 + 0.01 * nrm(ks[12], (DEPTH, SSM_GROUPS, SSM_STATE)),
        "ssm_lambda_im": lam_im + 0.01 * nrm(ks[13], (DEPTH, SSM_GROUPS, SSM_STATE)),
        "ssm_log_dt": jax.random.uniform(ks[14], (DEPTH, SSM_GROUPS), jnp.float32,
                                         math.log(1e-3), math.log(1e-1)),
        "ssm_b_re": nrm(ks[15], (DEPTH, SSM_GROUPS, SSM_STATE, SSM_GROUP)) * (0.5 / SSM_GROUP) ** 0.5,
        "ssm_b_im": nrm(ks[16], (DEPTH, SSM_GROUPS, SSM_STATE, SSM_GROUP)) * (0.5 / SSM_GROUP) ** 0.5,
        "ssm_c_re": 0.5 * nrm(ks[17], (DEPTH, SSM_GROUPS, SSM_GROUP, SSM_STATE)),
        "ssm_c_im": 0.5 * nrm(ks[18], (DEPTH, SSM_GROUPS, SSM_GROUP, SSM_STATE)),
        "ssm_d": nrm(ks[19], (DEPTH, D_SSM)),
        "ssm_glu_w": nrm(ks[20], (DEPTH, D_SSM, D_SSM)) * D_SSM ** -0.5,
        "ssm_glu_b": 0.01 * nrm(ks[21], (DEPTH, D_SSM)),
        "mem_norm_g": 1.0 + 0.01 * nrm(ks[22], (DEPTH, D_MODEL)),
        "w_kv": nrm(ks[23], (DEPTH, D_MODEL, 2 * D_XA)) * D_MODEL ** -0.5,
        "w_out": nrm(ks[24], (DEPTH, D_MIX, D_MODEL)) * D_MIX ** -0.5,
        "final_norm_g": 1.0 + 0.01 * nrm(ks[25], (D_MODEL,)),
    }


def reference(x_prompt, x_sample, mem_prompt, cache_conv, state_ssm_re, state_ssm_im, cache_mem_k,
              cache_mem_v, norm_g, w_in, conv_w, conv_b, ssm_lambda_re, ssm_lambda_im, ssm_log_dt,
              ssm_b_re, ssm_b_im, ssm_c_re, ssm_c_im, ssm_d, ssm_glu_w, ssm_glu_b, mem_norm_g, w_kv,
              w_out, final_norm_g):
    assert x_sample.shape[1] <= CHUNK
    f32 = jnp.float32
    bp = x_prompt.shape[0]
    xp, xs = x_prompt, x_sample
    p_conv, p_re, p_im, p_k, p_v = [], [], [], [], []
    s_conv, s_re, s_im = [], [], []
    for l in range(DEPTH):
        lw = (norm_g[l], w_in[l], conv_w[l], conv_b[l], ssm_lambda_re[l], ssm_lambda_im[l],
              ssm_log_dt[l], ssm_b_re[l], ssm_b_im[l], ssm_c_re[l], ssm_c_im[l], ssm_d[l],
              ssm_glu_w[l], ssm_glu_b[l], w_out[l])
        kp, vp = mem_kv(mem_prompt, mem_norm_g[l], w_kv[l])
        conv0 = jnp.zeros((bp, CONV_W - 1, D_CONV), xp.dtype)
        h0p = jnp.zeros((bp, SSM_GROUPS, SSM_STATE), jnp.complex64)
        xp, bufp, hp = layer(xp, conv0, h0p, kp, vp, *lw)
        p_conv.append(bufp)
        p_re.append(hp.real.astype(x_prompt.dtype))
        p_im.append(hp.imag.astype(x_prompt.dtype))
        p_k.append(kp)
        p_v.append(vp)
        h0s = lax.complex(state_ssm_re[l].astype(f32), state_ssm_im[l].astype(f32))
        xs, bufs, hs = layer(xs, cache_conv[l], h0s, cache_mem_k[l], cache_mem_v[l], *lw)
        s_conv.append(bufs)
        s_re.append(hs.real.astype(x_sample.dtype))
        s_im.append(hs.imag.astype(x_sample.dtype))
    y_prompt = rmsnorm(xp, final_norm_g)
    y_sample = rmsnorm(xs, final_norm_g)
    return (y_prompt, y_sample, jnp.stack(p_conv), jnp.stack(p_re), jnp.stack(p_im), jnp.stack(p_k),
            jnp.stack(p_v), jnp.stack(s_conv), jnp.stack(s_re), jnp.stack(s_im))
```

```cpp
#include <hip/hip_runtime.h>
#include <hip/hip_cooperative_groups.h>
#include <cstdio>
namespace cg = cooperative_groups;

#define LAS __attribute__((address_space(3)))
#define DEVI __device__ __forceinline__
typedef unsigned short bf16_t;
typedef short bf16x8 __attribute__((ext_vector_type(8)));
typedef float f32x4 __attribute__((ext_vector_type(4)));
typedef float f32x16 __attribute__((ext_vector_type(16)));
typedef unsigned u32x4 __attribute__((ext_vector_type(4)));
typedef unsigned u32x2 __attribute__((ext_vector_type(2)));

constexpr int MP = 16384, MT = 16640, MROWS_A = 16896;
constexpr int ZP = 6144;
constexpr int SL_GC = 0, SL_SGS = 1024, SL_Q = 2048, SL_U = 3072, SL_SU = 4096, SL_QGS = 5120;
constexpr float EPSF = 1e-6f;
constexpr int LDS_BYTES = 139264 + 16;
constexpr size_t O_PCONV = 17039360, O_PRE = 17043456, O_PIM = 17051648, O_PK = 17059840, O_PV = 17584128, O_SCONV = 18108416, O_SRE = 18141184, O_SIM = 18206720;
constexpr size_t DO_A1 = 0, DO_WT1 = 34603008, DO_WT2 = 55574528, DO_KV = 57671680;
constexpr size_t DO_HI = 0, DO_LO = 2048, HL_PITCH = 4096;
constexpr size_t WS_Z6 = 0, WS_WT1 = 204472320, WS_WT2 = 225443840, WS_WT3 = 227540992, WS_KV = 240123904, WS_E = 249561088, WS_PAR = 257949696, WS_ROWSS = 259194880, WS_SLAB = 259397632, WS_CTR = 265689088, WS_BAR = 265690112, WS_END = 265703936;
constexpr size_t PAR_L1 = 0, PAR_L64 = 32768, PAR_L1024 = 65536, PAR_BB = 98304, PAR_CM = 360448, PAR_STRIDE = 622592;
constexpr size_t WT3_STRIDE = 6291456;

#ifndef REP_P0
#define REP_P0 1
#endif
#ifndef REP_G1
#define REP_G1 1
#endif
#ifndef REP_S1
#define REP_S1 1
#endif
#ifndef EXTRA_SYNC
#define EXTRA_SYNC 0
#endif
#ifndef REP_SCAN
#define REP_SCAN 1
#endif
#ifndef REP_MIX
#define REP_MIX 1
#endif
#ifndef REP_S3
#define REP_S3 1
#endif
#ifndef REP_G23
#define REP_G23 1
#endif
struct P { const float* in[26]; float* out; unsigned char* ws; };

DEVI int fresh_tid() { int t = threadIdx.x; asm volatile("" : "+v"(t)); return t; }
DEVI unsigned cvt_pk_bf16(float lo, float hi) { unsigned r; asm("v_cvt_pk_bf16_f32 %0, %1, %2" : "=v"(r) : "v"(lo), "v"(hi)); return r; }
DEVI float bf_lo(unsigned w) { return __uint_as_float(w << 16); }
DEVI float bf_hi(unsigned w) { return __uint_as_float(w & 0xffff0000u); }
DEVI float sigm_f(float x) { return __builtin_amdgcn_rcpf(1.0f + __expf(-x)); }
DEVI float silu_f(float x) { return x * sigm_f(x); }
DEVI float gelu_f(float x) { return x * sigm_f(1.5957691216057308f * (x + 0.044715f * x * x * x)); }

namespace g8 {
constexpr int BM = 256, BK = 64, HALF = 128, HTB = HALF * BK * 2, NXCD = 8, WGM = 4;
DEVI int lds_byte(int r, int c) { const int st = (r >> 4) * 2 + (c >> 5), rr = r & 15, cc = c & 31, ob = rr * 64 + cc * 2; return st * 1024 + (ob ^ (((ob >> 9) & 1) << 5)); }
DEVI void stage_rc(int b, int& R, int& C) { const int st = b / 1024, sb = b % 1024, swz = sb ^ (((sb >> 9) & 1) << 5); R = (st >> 1) * 16 + swz / 64; C = (st & 1) * 32 + (swz % 64) / 2; }

struct GUnit { const char* a; const char* b; int pm, pn, kind, lay; };

struct Sched {
    int mode;
    int nM, nN, nwg, G, c, nextra;
    const char* A; const char* B; size_t tA, tB, koff;
    const char* Ax; const char* Bx0; const char* Bx1;
    unsigned kmap;
    DEVI bool next(int i, GUnit& u) const {
        const int L = i * G + c;
        if (L >= nwg + nextra) return false;
        if (mode == 0) {
            int wgid = L; { const int q = nwg / NXCD, r = nwg % NXCD, xcd = wgid % NXCD, off = wgid / NXCD; wgid = (xcd < r ? xcd * (q + 1) : r * (q + 1) + (xcd - r) * q) + off; }
            const int nig = WGM * nN, gid = wgid / nig, fm = gid * WGM, gsz = (nM - fm) < WGM ? (nM - fm) : WGM;
            u.pm = fm + ((wgid % nig) % gsz); u.pn = (wgid % nig) / gsz; u.kind = 0; u.lay = 0;
            u.a = A + (size_t)u.pm * tA; u.b = B + (size_t)u.pn * tB;
        } else if (mode == 1) {
            if (L < nwg) { u.pm = 64; u.pn = L; u.kind = 0; u.lay = 0; u.a = A + (size_t)64 * tA; u.b = B + (size_t)L * tB; }
            else { const int x = L - nwg; u.lay = x >> 3; u.pn = x & 7; u.pm = 65; u.kind = 1; u.a = Ax; u.b = (u.lay ? Bx1 : Bx0) + (size_t)(32 + u.pn) * tB; }
        } else {
            u.pm = 64; u.pn = L % nN; u.lay = (int)((kmap >> (4 * (L / nN))) & 15u); u.kind = 0;
            u.a = A + (size_t)64 * tA + (size_t)u.lay * koff; u.b = B + (size_t)u.pn * tB + (size_t)u.lay * koff;
        }
        return true;
    }
};

template <class T, class = void> struct after_drain_t { static constexpr bool value = false; };
template <class T> struct after_drain_t<T, decltype((void)T::AFTER_DRAIN)> { static constexpr bool value = T::AFTER_DRAIN; };
template <class T> constexpr bool after_drain_v = after_drain_t<T>::value;
template <class Epi>
DEVI void gemm_phase(LAS unsigned char* lds, const int K, const int lda, const int ldb, const Sched& S, const Epi& E) {
    const int tid = fresh_tid(), wid = __builtin_amdgcn_readfirstlane(tid >> 6), lane = tid & 63, wr = wid >> 2, wc = wid & 3, fr = lane & 15, fq = lane >> 4;
    const int nt = K / BK;
    unsigned voffA[2], voffB[2];
#pragma unroll
    for (int i = 0; i < 2; ++i) { int R, C; stage_rc(tid * 16 + i * 8192, R, C); voffA[i] = (unsigned)(R * lda + C) * 2u; voffB[i] = (unsigned)(R * ldb + C) * 2u; }
    const size_t kstep = (size_t)(BK * 2);
    const size_t hA = (size_t)HALF * lda * 2, hB = (size_t)HALF * ldb * 2;
    const unsigned ldsw = (unsigned)wid * 1024u;
    const int aoff = lds_byte(wr * 64 + fr, fq * 8), boff = lds_byte(wc * 32 + fr, fq * 8);
#define PG8_SA(b, h) (((b) * 2 + (h)) * HTB)
#define PG8_SB(b, h) ((4 + (b) * 2 + (h)) * HTB)
#define PG8_STAGE(bufoff, gbase, voff) do { _Pragma("unroll") for (int _i = 0; _i < 2; ++_i) \
        __builtin_amdgcn_global_load_lds((const unsigned*)((const char*)(gbase) + (voff)[_i]), (LAS unsigned*)(lds + (bufoff) + ldsw + _i * 8192), 16, 0, 0); } while (0)
#define PG8_LDA(dst, b, h) do { _Pragma("unroll") for (int m = 0; m < 4; ++m) _Pragma("unroll") for (int k = 0; k < 2; ++k) dst[m][k] = *(const LAS bf16x8*)(lds + PG8_SA(b, h) + aoff + m * 2048 + k * 1024); } while (0)
#define PG8_LDB(dst, b, h) do { _Pragma("unroll") for (int n = 0; n < 2; ++n) _Pragma("unroll") for (int k = 0; k < 2; ++k) dst[n][k] = *(const LAS bf16x8*)(lds + PG8_SB(b, h) + boff + n * 2048 + k * 1024); } while (0)
#define PG8_MMA(ai, bj, At, Bt) do { __builtin_amdgcn_s_setprio(1); _Pragma("unroll") for (int m = 0; m < 4; ++m) _Pragma("unroll") for (int n = 0; n < 2; ++n) _Pragma("unroll") for (int k = 0; k < 2; ++k) \
        acc[ai][bj][m][n] = __builtin_amdgcn_mfma_f32_16x16x32_bf16(Bt[n][k], At[m][k], acc[ai][bj][m][n], 0, 0, 0); __builtin_amdgcn_s_setprio(0); } while (0)
#define PG8_WAIT_V(n) asm volatile("s_waitcnt vmcnt(" #n ")" ::: "memory")
#define PG8_WAIT_L(n) asm volatile("s_waitcnt lgkmcnt(" #n ")" ::: "memory")
#define PG8_BAR __builtin_amdgcn_s_barrier()
#define PG8_SCHED __builtin_amdgcn_sched_barrier(0)
    GUnit cur, nxt; int ui = 0;
    if (!S.next(0, cur)) return;
    f32x4 acc[2][2][4][2];
#pragma unroll
    for (int a = 0; a < 2; ++a)
#pragma unroll
        for (int b = 0; b < 2; ++b)
#pragma unroll
            for (int m = 0; m < 4; ++m)
#pragma unroll
                for (int n = 0; n < 2; ++n) acc[a][b][m][n] = (f32x4){0.f, 0.f, 0.f, 0.f};
    bf16x8 At[4][2], B0[2][2], B1[2][2];
    const char* cA = cur.a; const char* cB = cur.b;
    PG8_STAGE(PG8_SB(0, 0), cB, voffB); PG8_STAGE(PG8_SA(0, 0), cA, voffA); PG8_STAGE(PG8_SB(0, 1), cB + hB, voffB); PG8_STAGE(PG8_SA(0, 1), cA + hA, voffA);
    if (wr == 1) PG8_BAR;
    PG8_WAIT_V(4); PG8_BAR;
    PG8_STAGE(PG8_SB(1, 0), cB + kstep, voffB); PG8_STAGE(PG8_SA(1, 0), cA + kstep, voffA); PG8_STAGE(PG8_SB(1, 1), cB + hB + kstep, voffB);
    PG8_WAIT_V(6); PG8_BAR;
    for (;;) {
        const bool has_next = S.next(ui + 1, nxt);
        const char* nA = has_next ? nxt.a : cA; const char* nB = has_next ? nxt.b : cB;
        for (int t = 0; t < nt; t += 2) {
            const bool last = (t == nt - 2);
            const char* a1 = cA + (size_t)(t + 1) * kstep;
            const char* a2 = last ? nA : cA + (size_t)(t + 2) * kstep; const char* b2 = last ? nB : cB + (size_t)(t + 2) * kstep;
            const char* a3 = a2 + kstep; const char* b3 = b2 + kstep;
            PG8_LDB(B0, 0, 0); PG8_SCHED; PG8_LDA(At, 0, 0); PG8_STAGE(PG8_SA(1, 1), a1 + hA, voffA);
            PG8_WAIT_L(8); PG8_BAR; PG8_WAIT_L(0); PG8_MMA(0, 0, At, B0); PG8_BAR; PG8_SCHED;
            PG8_LDB(B1, 0, 1); PG8_STAGE(PG8_SB(0, 0), b2, voffB);
            PG8_BAR; PG8_WAIT_L(0); PG8_MMA(0, 1, At, B1); PG8_BAR;
            PG8_LDA(At, 0, 1); PG8_STAGE(PG8_SA(0, 0), a2, voffA);
            PG8_BAR; PG8_WAIT_L(0); PG8_MMA(1, 0, At, B0); PG8_BAR; PG8_SCHED;
            PG8_STAGE(PG8_SB(0, 1), b2 + hB, voffB);
            PG8_WAIT_V(6); PG8_BAR; PG8_MMA(1, 1, At, B1); PG8_BAR;
            PG8_LDB(B0, 1, 0); PG8_SCHED; PG8_LDA(At, 1, 0); PG8_STAGE(PG8_SA(0, 1), a2 + hA, voffA);
            PG8_WAIT_L(8); PG8_BAR; PG8_WAIT_L(0); PG8_MMA(0, 0, At, B0); PG8_BAR; PG8_SCHED;
            PG8_LDB(B1, 1, 1); PG8_STAGE(PG8_SB(1, 0), b3, voffB);
            PG8_BAR; PG8_WAIT_L(0); PG8_MMA(0, 1, At, B1); PG8_BAR;
            PG8_LDA(At, 1, 1); PG8_STAGE(PG8_SA(1, 0), a3, voffA);
            PG8_BAR; PG8_WAIT_L(0); PG8_MMA(1, 0, At, B0); PG8_BAR; PG8_SCHED;
            PG8_STAGE(PG8_SB(1, 1), b3 + hB, voffB);
            PG8_WAIT_V(6); PG8_BAR; PG8_MMA(1, 1, At, B1); PG8_BAR;
        }
        if constexpr (!after_drain_v<Epi>) E(acc, cur, wr, wc, fr, fq);
        if (!has_next) break;
#pragma unroll
        for (int a = 0; a < 2; ++a)
#pragma unroll
            for (int b = 0; b < 2; ++b)
#pragma unroll
                for (int m = 0; m < 4; ++m)
#pragma unroll
                    for (int n = 0; n < 2; ++n) acc[a][b][m][n] = (f32x4){0.f, 0.f, 0.f, 0.f};
        cur = nxt; cA = nA; cB = nB; ++ui;
    }
    PG8_WAIT_V(0);
    if (wr == 0) PG8_BAR;
    PG8_BAR;
    if constexpr (after_drain_v<Epi>) E.fused(acc, cur, wr, wc, fr, fq);
#undef PG8_SA
#undef PG8_SB
#undef PG8_STAGE
#undef PG8_LDA
#undef PG8_LDB
#undef PG8_MMA
#undef PG8_WAIT_V
#undef PG8_WAIT_L
#undef PG8_BAR
#undef PG8_SCHED
}
}

DEVI u32x4 pack8(const float (&v)[8]) { u32x4 w; w.x = cvt_pk_bf16(v[0], v[1]); w.y = cvt_pk_bf16(v[2], v[3]); w.z = cvt_pk_bf16(v[4], v[5]); w.w = cvt_pk_bf16(v[6], v[7]); return w; }

struct Epi1 {
    bf16_t* z6; const float* rowss; const float* rowss_mem; float* out; bf16_t* kv0; bf16_t* kv1;
    DEVI void operator()(const f32x4 (&acc)[2][2][4][2], const g8::GUnit& u, int wr, int wc, int fr, int fq) const {
        asm volatile("" : "+v"(fr), "+v"(fq));
        if (u.kind == 0) {
            const int pn = u.pn;
#pragma unroll
            for (int ai = 0; ai < 2; ++ai)
#pragma unroll
                for (int m = 0; m < 4; ++m) {
                    const int row = u.pm * 256 + ai * 128 + wr * 64 + m * 16 + fr;
                    const float rs = rowss ? __builtin_amdgcn_rsqf(rowss[row] * (1.0f / 1024.0f) + EPSF) : 1.0f;
                    bf16_t* zr = z6 + (size_t)row * ZP + wc * 32 + fq * 8;
                    if (pn < 16) {
                        float v[8];
#pragma unroll
                        for (int n = 0; n < 2; ++n)
#pragma unroll
                            for (int e = 0; e < 4; ++e) { const float a = acc[ai][0][m][n][e] * rs, b = acc[ai][1][m][n][e] * rs; v[4 * n + e] = (pn < 8) ? a * b : a * silu_f(b); }
                        const int col = (pn < 8) ? (SL_U + 128 * pn) : (SL_GC + 128 * (pn - 8));
                        *(u32x4*)(zr + col) = pack8(v);
                    } else {
                        const int part = (pn - 16) >> 2, cb = (pn - 16) & 3;
                        const int slot = part == 0 ? SL_SU : part == 1 ? SL_SGS : part == 2 ? SL_Q : SL_QGS;
#pragma unroll
                        for (int bj = 0; bj < 2; ++bj) {
                            float v[8];
#pragma unroll
                            for (int n = 0; n < 2; ++n)
#pragma unroll
                                for (int e = 0; e < 4; ++e) { const float a = acc[ai][bj][m][n][e] * rs; v[4 * n + e] = (part == 2) ? a * 0.0625f : a; }
                            *(u32x4*)(zr + slot + 256 * cb + 128 * bj) = pack8(v);
                        }
                    }
                    asm volatile("" ::: "memory");
                }
        } else {
            const int lk = u.lay, pnk = u.pn, isv = pnk >> 2, h = pnk & 3;
            bf16_t* kvb = (lk ? kv1 : kv0) + (size_t)h * 131072 + (isv ? 65536 : 0);
            float* o32 = out + (isv ? O_PV : O_PK) + (size_t)lk * 262144 + h * 256;
#pragma unroll
            for (int ai = 0; ai < 2; ++ai)
#pragma unroll
                for (int m = 0; m < 4; ++m) {
                    const int key = ai * 128 + wr * 64 + m * 16 + fr;
                    const float rs = 1.0f;
#pragma unroll
                    for (int bj = 0; bj < 2; ++bj) {
                        const int d0 = 128 * bj + 32 * wc + 8 * fq;
                        float v[8];
#pragma unroll
                        for (int n = 0; n < 2; ++n)
#pragma unroll
                            for (int e = 0; e < 4; ++e) v[4 * n + e] = acc[ai][bj][m][n][e] * rs;
                        *(f32x4*)(o32 + (size_t)key * 1024 + d0) = (f32x4){v[0], v[1], v[2], v[3]};
                        *(f32x4*)(o32 + (size_t)key * 1024 + d0 + 4) = (f32x4){v[4], v[5], v[6], v[7]};
                        if (!isv) *(u32x4*)(kvb + key * 256 + d0) = pack8(v);
                        else {
                            const int k5 = key & 31, slot = (key & ~31) + 8 * ((k5 >> 2) & 3) + 4 * (k5 >> 4) + (k5 & 3);
#pragma unroll
                            for (int j = 0; j < 8; ++j) kvb[(d0 + j) * 256 + slot] = (bf16_t)(cvt_pk_bf16(v[j], 0.f) & 0xffffu);
                        }
                        asm volatile("" ::: "memory");
                    }
                }
        }
    }
};

struct Epi2 {
    bf16_t* z6; const float* glu_b; int oslot;
    DEVI void operator()(const f32x4 (&acc)[2][2][4][2], const g8::GUnit& u, int wr, int wc, int fr, int fq) const {
        asm volatile("" : "+v"(fr), "+v"(fq));
#pragma unroll
        for (int bj = 0; bj < 2; ++bj) {
            const int c0 = u.pn * 256 + 128 * bj + 32 * wc + 8 * fq;
            const f32x4 b0 = *(const f32x4*)(glu_b + c0), b1 = *(const f32x4*)(glu_b + c0 + 4);
            u32x4 sgv[2][4];
#pragma unroll
            for (int ai = 0; ai < 2; ++ai)
#pragma unroll
                for (int m = 0; m < 4; ++m) sgv[ai][m] = *(const u32x4*)(z6 + (size_t)(u.pm * 256 + ai * 128 + wr * 64 + m * 16 + fr) * ZP + c0 + SL_SGS);
#pragma unroll
            for (int ai = 0; ai < 2; ++ai)
#pragma unroll
                for (int m = 0; m < 4; ++m) {
                    const int row = u.pm * 256 + ai * 128 + wr * 64 + m * 16 + fr;
                    bf16_t* zr = z6 + (size_t)row * ZP + c0;
                    const u32x4 sg = sgv[ai][m];
                    float v[8];
#pragma unroll
                    for (int n = 0; n < 2; ++n)
#pragma unroll
                        for (int e = 0; e < 4; ++e) {
                            const int j = 4 * n + e; const unsigned sw = sg[j >> 1];
                            const float s = (j & 1) ? bf_hi(sw) : bf_lo(sw);
                            v[j] = s * sigm_f(acc[ai][bj][m][n][e] + (n ? b1[e] : b0[e]));
                        }
                    *(u32x4*)(zr + oslot) = pack8(v);
                }
        }
    }
};

struct Epi3 {
    static constexpr bool AFTER_DRAIN = true;
    int lay; const float* xp; unsigned char* dout; float* rowss_next; unsigned* pctr; const float* gfin;
    DEVI void fused(f32x4 (&acc)[2][2][4][2], const g8::GUnit& u, int wr, int wc, int fr, int fq) const {
        asm volatile("" : "+v"(fr), "+v"(fq));
#pragma unroll
        for (int aq = 0; aq < 4; ++aq) {
            const int ai = aq >> 1, mh = (aq & 1) * 2;
            f32x4 rx[2][2][2]; u32x4 hx[2][2];
#pragma unroll
            for (int m2 = 0; m2 < 2; ++m2)
#pragma unroll
                for (int bj = 0; bj < 2; ++bj) {
                    const int prow = u.pm * 256 + ai * 128 + wr * 64 + (mh + m2) * 16 + fr, pc0 = u.pn * 256 + 128 * bj + 32 * wc + 8 * fq;
                    if (lay == 0) { const float* xq = xp + (size_t)prow * 1024 + pc0; rx[m2][bj][0] = *(const f32x4*)xq; rx[m2][bj][1] = *(const f32x4*)(xq + 4); }
                    else hx[m2][bj] = *(const u32x4*)(dout + DO_HI + (size_t)prow * HL_PITCH + pc0 * 2);
                }
#pragma unroll
            for (int m2 = 0; m2 < 2; ++m2) {
                const int m = mh + m2;
                const int row = u.pm * 256 + ai * 128 + wr * 64 + m * 16 + fr;
                float ss = 0.f;
#pragma unroll
                for (int bj = 0; bj < 2; ++bj) {
                    const int c0 = u.pn * 256 + 128 * bj + 32 * wc + 8 * fq;
                    float v[8];
                    if (lay == 0) {
                        const f32x4 r0 = rx[m2][bj][0], r1 = rx[m2][bj][1];
#pragma unroll
                        for (int e = 0; e < 4; ++e) { v[e] = r0[e] + acc[ai][bj][m][0][e]; v[4 + e] = r1[e] + acc[ai][bj][m][1][e]; }
                        *(u32x4*)(dout + DO_HI + (size_t)row * HL_PITCH + c0 * 2) = pack8(v);
                    } else {
                        const u32x4 hi = hx[m2][bj];
#pragma unroll
                        for (int n = 0; n < 2; ++n)
#pragma unroll
                            for (int e = 0; e < 4; ++e) { const int j = 4 * n + e; v[j] = ((j & 1) ? bf_hi(hi[j >> 1]) : bf_lo(hi[j >> 1])) + acc[ai][bj][m][n][e]; }
                        acc[ai][bj][m][0] = (f32x4){v[0], v[1], v[2], v[3]}; acc[ai][bj][m][1] = (f32x4){v[4], v[5], v[6], v[7]};
                    }
#pragma unroll
                    for (int j = 0; j < 8; ++j) ss += v[j] * v[j];
                }
                ss += __shfl_xor(ss, 16); ss += __shfl_xor(ss, 32);
                if (fq == 0) atomicAdd(rowss_next + row, ss);
            }
        }
        if (lay == 0) return;
        asm volatile("s_waitcnt vmcnt(0)" ::: "memory");
        __syncthreads();
        if (threadIdx.x == 0) {
            __hip_atomic_fetch_add(pctr + u.pm, 1u, __ATOMIC_RELAXED, __HIP_MEMORY_SCOPE_AGENT);
            unsigned sp = 0;
            while (__hip_atomic_load(pctr + u.pm, __ATOMIC_RELAXED, __HIP_MEMORY_SCOPE_AGENT) < 4u) { __builtin_amdgcn_s_sleep(2); if (++sp > (1u << 22)) break; }
        }
        __syncthreads();
#pragma unroll
        for (int ai = 0; ai < 2; ++ai)
#pragma unroll
            for (int m = 0; m < 4; ++m) {
                const int row = u.pm * 256 + ai * 128 + wr * 64 + m * 16 + fr;
                const float rs = __builtin_amdgcn_rsqf(__hip_atomic_load(rowss_next + row, __ATOMIC_RELAXED, __HIP_MEMORY_SCOPE_AGENT) * (1.0f / 1024.0f) + EPSF);
#pragma unroll
                for (int bj = 0; bj < 2; ++bj) {
                    const int c0 = u.pn * 256 + 128 * bj + 32 * wc + 8 * fq;
                    const f32x4 g0 = *(const f32x4*)(gfin + c0), g1 = *(const f32x4*)(gfin + c0 + 4);
                    float* yo = (float*)(dout + (size_t)row * 4096) + c0;
                    *(f32x4*)yo = acc[ai][bj][m][0] * rs * g0; *(f32x4*)(yo + 4) = acc[ai][bj][m][1] * rs * g1;
                }
            }
    }
};
struct Epi3s {
    float* slab;
    DEVI void operator()(const f32x4 (&acc)[2][2][4][2], const g8::GUnit& u, int wr, int wc, int fr, int fq) const {
        asm volatile("" : "+v"(fr), "+v"(fq));
        float* sb = slab + (size_t)u.lay * 262144;
#pragma unroll
        for (int ai = 0; ai < 2; ++ai)
#pragma unroll
            for (int m = 0; m < 4; ++m) {
                const int r = ai * 128 + wr * 64 + m * 16 + fr;
#pragma unroll
                for (int bj = 0; bj < 2; ++bj) {
                    float* o = sb + (size_t)r * 1024 + u.pn * 256 + 128 * bj + 32 * wc + 8 * fq;
                    *(f32x4*)o = acc[ai][bj][m][0]; *(f32x4*)(o + 4) = acc[ai][bj][m][1];
                }
            }
    }
};

DEVI void finalize_sample(int r, int l, const P& p, const float* slab, float* rowss_next) {
    const int lane = fresh_tid() & 63, row = MP + r;
    unsigned char* dout = (unsigned char*)p.out;
    float ss = 0.f; f32x4 v[4];
#pragma unroll
    for (int i = 0; i < 4; ++i) {
        const int c = (lane + 64 * i) * 4;
        v[i] = *(const f32x4*)(slab + (size_t)r * 1024 + c);
#pragma unroll
        for (int k = 1; k < 6; ++k) v[i] = v[i] + *(const f32x4*)(slab + (size_t)k * 262144 + (size_t)r * 1024 + c);
        if (l == 0) v[i] = v[i] + *(const f32x4*)(p.in[1] + (size_t)r * 1024 + c);
        else {
            const u32x2 hi = *(const u32x2*)(dout + DO_HI + (size_t)row * HL_PITCH + c * 2), lo = *(const u32x2*)(dout + DO_LO + (size_t)row * HL_PITCH + c * 2);
            v[i] = v[i] + (f32x4){bf_lo(hi.x) + bf_lo(lo.x), bf_hi(hi.x) + bf_hi(lo.x), bf_lo(hi.y) + bf_lo(lo.y), bf_hi(hi.y) + bf_hi(lo.y)};
        }
        ss += v[i][0] * v[i][0] + v[i][1] * v[i][1] + v[i][2] * v[i][2] + v[i][3] * v[i][3];
    }
#pragma unroll
    for (int o = 32; o >= 1; o >>= 1) ss += __shfl_xor(ss, o);
    if (l == 0) {
#pragma unroll
        for (int i = 0; i < 4; ++i) {
            const int c = (lane + 64 * i) * 4;
            u32x2 hi; hi.x = cvt_pk_bf16(v[i][0], v[i][1]); hi.y = cvt_pk_bf16(v[i][2], v[i][3]);
            u32x2 lo; lo.x = cvt_pk_bf16(v[i][0] - bf_lo(hi.x), v[i][1] - bf_hi(hi.x)); lo.y = cvt_pk_bf16(v[i][2] - bf_lo(hi.y), v[i][3] - bf_hi(hi.y));
            *(u32x2*)(dout + DO_HI + (size_t)row * HL_PITCH + c * 2) = hi;
            *(u32x2*)(dout + DO_LO + (size_t)row * HL_PITCH + c * 2) = lo;
        }
        if (lane == 0) rowss_next[row] = ss;
    } else {
        const float rs = __builtin_amdgcn_rsqf(ss * (1.0f / 1024.0f) + EPSF);
#pragma unroll
        for (int i = 0; i < 4; ++i) {
            const int c = (lane + 64 * i) * 4;
            const f32x4 gg = *(const f32x4*)(p.in[25] + c);
            *(f32x4*)(p.out + (size_t)row * 1024 + c) = v[i] * rs * gg;
        }
    }
}

DEVI void group_barrier(unsigned* ctr, unsigned target) {
    __syncthreads();
    if (threadIdx.x == 0) {
        __threadfence();
        __hip_atomic_fetch_add(ctr, 1u, __ATOMIC_RELAXED, __HIP_MEMORY_SCOPE_AGENT);
        while (__hip_atomic_load(ctr, __ATOMIC_RELAXED, __HIP_MEMORY_SCOPE_AGENT) < target) __builtin_amdgcn_s_sleep(4);
        __threadfence();
    }
    __syncthreads();
}

#define XB_TMO      128
#define XB_XCNT(j)  (256  + 64 * (j))
#define XB_XSUB(j)  (1280 + 64 * (j))
#define XB_XGEN(j)  (2304 + 64 * (j))
#define XB_TOP      3328
#define XB_TOPGEN   3392
#define XCD_BAR_WORDS 3456
#define XB_SPIN_CAP (1u << 18)
DEVI unsigned xb_ld(unsigned* p)              { return __hip_atomic_load(p, __ATOMIC_RELAXED, __HIP_MEMORY_SCOPE_AGENT); }
DEVI unsigned xb_add(unsigned* p, unsigned v) { return __hip_atomic_fetch_add(p, v, __ATOMIC_RELAXED, __HIP_MEMORY_SCOPE_AGENT); }
DEVI unsigned xb_xcc_id() { return (unsigned)__builtin_amdgcn_s_getreg((3 << 11) | 20) & 0xFu; }
#define XB_SPIN(cond, bar) do { unsigned _sp = 0; while (cond) { __builtin_amdgcn_s_sleep(1); \
    if ((++_sp & 255u) == 0u) { if (xb_ld(&(bar)[XB_TMO])) break; if (_sp > XB_SPIN_CAP) { atomicAdd(&(bar)[XB_TMO], 1u); break; } } } } while (0)
struct XcdBarrier { unsigned* bar; unsigned x; volatile LAS unsigned* st; };
DEVI XcdBarrier xcd_barrier_post(unsigned* bar, volatile LAS unsigned* st) {
    XcdBarrier b; b.bar = bar; b.x = xb_xcc_id(); b.st = st;
    if (threadIdx.x == 0) (void)xb_add(&bar[XB_XCNT(b.x)], 1u);
    return b;
}
DEVI void xcd_barrier_complete(unsigned* bar, unsigned x, unsigned& nloc, unsigned& nx) {
    const unsigned G = gridDim.x * gridDim.y * gridDim.z;
    unsigned sum, cnt, mine, sp = 0u;
    for (;;) {
        sum = 0u; cnt = 0u; mine = 0u;
#pragma unroll
        for (unsigned j = 0; j < 16; ++j) { const unsigned c = xb_ld(&bar[XB_XCNT(j)]); sum += c; cnt += (c > 0u) ? 1u : 0u; mine = (j == x) ? c : mine; }
        if (sum == G) break;
        __builtin_amdgcn_s_sleep(1);
        if ((++sp & 255u) == 0u) { if (xb_ld(&bar[XB_TMO])) break; if (sp > XB_SPIN_CAP) { atomicAdd(&bar[XB_TMO], 1u); break; } }
    }
    nloc = mine > 0u ? mine : 1u; nx = cnt > 0u ? cnt : 1u;
}
DEVI void xcd_barrier(const XcdBarrier& b) {
    asm volatile("s_waitcnt vmcnt(0)" ::: "memory");
    __syncthreads();
    if (threadIdx.x == 0) {
        unsigned* bar = b.bar;
        __builtin_amdgcn_s_waitcnt(0);
        unsigned nloc = b.st[0], nx = b.st[1];
        if (nloc == 0u) { xcd_barrier_complete(bar, b.x, nloc, nx); b.st[0] = nloc; b.st[1] = nx; }
        const unsigned old = xb_add(&bar[XB_XSUB(b.x)], 1u);
        const unsigned gen = old / nloc;
        if (old + 1u == (gen + 1u) * nloc) {
            __builtin_amdgcn_fence(__ATOMIC_RELEASE, "agent");
            asm volatile("s_waitcnt vmcnt(0)" ::: "memory");
            const unsigned og = xb_add(&bar[XB_TOP], 1u);
            const unsigned tg = og / nx;
            if (og + 1u == (tg + 1u) * nx) xb_add(&bar[XB_TOPGEN], 1u);
            else XB_SPIN(xb_ld(&bar[XB_TOPGEN]) == tg, bar);
            __builtin_amdgcn_fence(__ATOMIC_ACQUIRE, "agent");
            xb_add(&bar[XB_XGEN(b.x)], 1u);
            asm volatile("s_waitcnt vmcnt(0)" ::: "memory");
        } else {
            XB_SPIN(xb_ld(&bar[XB_XGEN(b.x)]) == gen, bar);
            __builtin_amdgcn_fence(__ATOMIC_ACQUIRE, "agent");
            asm volatile("s_waitcnt vmcnt(0)" ::: "memory");
        }
    }
    __syncthreads();
}

DEVI double d_exp(double x) {
    const double kf = __builtin_rint(x * 1.4426950408889634);
    double r = __builtin_fma(-kf, 0.6931471803691238, x); r = __builtin_fma(-kf, 1.9082149292705877e-10, r);
    double p = 1.0 / 6227020800.0;
    p = p * r + 1.0 / 479001600.0; p = p * r + 1.0 / 39916800.0; p = p * r + 1.0 / 3628800.0; p = p * r + 1.0 / 362880.0; p = p * r + 1.0 / 40320.0;
    p = p * r + 1.0 / 5040.0; p = p * r + 1.0 / 720.0; p = p * r + 1.0 / 120.0; p = p * r + 1.0 / 24.0; p = p * r + 1.0 / 6.0; p = p * r + 0.5; p = p * r + 1.0; p = p * r + 1.0;
    const long long k = (long long)kf;
    return p * __longlong_as_double((k + 1023) << 52);
}
DEVI void d_sincos(double th, double& s, double& c) {
    const double q = __builtin_rint(th * 0.6366197723675814);
    double r = __builtin_fma(-q, 1.5707963267948966, th); r = __builtin_fma(-q, 6.123233995736766e-17, r);
    const double r2 = r * r;
    double ps = -1.0 / 121645100408832000.0;
    ps = ps * r2 + 1.0 / 355687428096000.0; ps = ps * r2 - 1.0 / 1307674368000.0; ps = ps * r2 + 1.0 / 6227020800.0; ps = ps * r2 - 1.0 / 39916800.0;
    ps = ps * r2 + 1.0 / 362880.0; ps = ps * r2 - 1.0 / 5040.0; ps = ps * r2 + 1.0 / 120.0; ps = ps * r2 - 1.0 / 6.0; ps = ps * r2 + 1.0;
    const double sr = ps * r;
    double pc = 1.0 / 2432902008176640000.0;
    pc = pc * r2 - 1.0 / 6402373705728000.0; pc = pc * r2 + 1.0 / 20922789888000.0; pc = pc * r2 - 1.0 / 87178291200.0; pc = pc * r2 + 1.0 / 479001600.0;
    pc = pc * r2 - 1.0 / 3628800.0; pc = pc * r2 + 1.0 / 40320.0; pc = pc * r2 - 1.0 / 720.0; pc = pc * r2 + 1.0 / 24.0; pc = pc * r2 - 0.5; pc = pc * r2 + 1.0;
    const int qi = ((int)q) & 3;
    s = (qi == 0) ? sr : (qi == 1) ? pc : (qi == 2) ? -sr : -pc;
    c = (qi == 0) ? pc : (qi == 1) ? -sr : (qi == 2) ? -pc : sr;
}

DEVI void transpose_strip(LAS float* T, const float* src, int ld, int k0, int s0, const float* scale, bf16_t* dst, int ldd, int j0, bool rowperm, bool colperm) {
    const int tid = fresh_tid();
    __syncthreads();
    {
        f32x4 v[8];
#pragma unroll
        for (int i = 0; i < 8; ++i) {
            const int idx = tid + 512 * i, kk = idx >> 4, c4 = idx & 15; int sr = k0 + kk;
            if (rowperm) { const int s5 = sr & 31; sr = (sr & ~31) + 16 * ((s5 >> 2) & 1) + 4 * (s5 >> 3) + (s5 & 3); }
            v[i] = *(const f32x4*)(src + (size_t)sr * ld + s0 + 4 * c4);
            if (scale) { const float sc = scale[k0 + kk]; v[i] = v[i] * sc; }
        }
#pragma unroll
        for (int i = 0; i < 8; ++i) {
            const int idx = tid + 512 * i, kk = idx >> 4, c4 = idx & 15;
#pragma unroll
            for (int e = 0; e < 4; ++e) T[(4 * c4 + e) * 257 + kk] = v[i][e];
        }
    }
    __syncthreads();
    {
        const int k2 = (tid & 31) * 2, jb = tid >> 5;
#pragma unroll
        for (int i = 0; i < 4; ++i) {
            const int jj = jb + 16 * i;
            const int cs = colperm ? (32 * (jj >> 5) + 8 * ((jj >> 2) & 3) + 4 * ((jj >> 4) & 1) + (jj & 3)) : jj;
#pragma unroll
            for (int m = 0; m < 4; ++m)
                *(unsigned*)(dst + (size_t)(j0 + jj) * ldd + k0 + 64 * m + k2) = cvt_pk_bf16(T[cs * 257 + 64 * m + k2], T[cs * 257 + 64 * m + k2 + 1]);
        }
    }
}

DEVI void weight_strip(const P& p, LAS float* T, int l, int idx) {
    unsigned char* dout = (unsigned char*)p.out;
    if (idx < 512) {
        const int jt = idx >> 2, ks = idx & 3, j0 = jt * 64, pn = j0 >> 8, bj = (j0 >> 7) & 1, hh = (j0 >> 6) & 1;
        int s0;
        if (pn < 8) s0 = (bj ? 2 : 0) * 1024 + 128 * pn + 64 * hh;
        else if (pn < 16) s0 = (bj ? 3 : 1) * 1024 + 128 * (pn - 8) + 64 * hh;
        else s0 = (4 + ((pn - 16) >> 2)) * 1024 + 256 * ((pn - 16) & 3) + 128 * bj + 64 * hh;
        bf16_t* dst = (bf16_t*)(l ? p.ws + WS_WT1 : dout + DO_WT1);
        transpose_strip(T, p.in[9] + (size_t)l * 1024 * 8192, 8192, ks * 256, s0, p.in[8] + l * 1024, dst, 1024, j0, false, true);
    } else if (idx < 640) {
        const int x = idx - 512, jt = x >> 2, ks = x & 3;
        bf16_t* dst = (bf16_t*)(l ? p.ws + WS_WT1 : dout + DO_WT1);
        transpose_strip(T, p.in[23] + (size_t)l * 1024 * 2048, 2048, ks * 256, jt * 64, p.in[22] + l * 1024, dst, 1024, 8192 + jt * 64, false, true);
    } else if (idx < 704) {
        const int x = idx - 640, jt = x >> 2, ks = x & 3;
        bf16_t* dst = (bf16_t*)(l ? p.ws + WS_WT2 : dout + DO_WT2);
        transpose_strip(T, p.in[20] + (size_t)l * 1024 * 1024, 1024, ks * 256, jt * 64, nullptr, dst, 1024, jt * 64, false, true);
    } else {
        const int x = idx - 704, jt = x / 12, ks = x % 12;
        bf16_t* dst = (bf16_t*)(p.ws + WS_WT3 + (size_t)l * WT3_STRIDE);
        transpose_strip(T, p.in[24] + (size_t)l * 3072 * 1024, 1024, ks * 256, jt * 64, nullptr, dst, 3072, jt * 64, false, true);
    }
}

DEVI void phase0(const P& p, LAS unsigned char* lds) {
    const int tid = fresh_tid(), G = gridDim.x, bid = blockIdx.x, lane = tid & 63, wid = tid >> 6;
    unsigned char* dout = (unsigned char*)p.out;
    LAS float* T = (LAS float*)lds;
    for (int it = bid; it < 896 + 128; it += G) { if (it < 896) weight_strip(p, T, 0, it); else weight_strip(p, T, 1, 512 + (it - 896)); }
    for (int it = bid; it < 256; it += G) {
        const int l = it >> 7, b = (it >> 4) & 7, h = (it >> 2) & 3, jt = it & 3;
        bf16_t* dst = (bf16_t*)(l ? p.ws + WS_KV : dout + DO_KV) + (size_t)(1 + b) * 524288 + (size_t)h * 131072 + 65536;
        transpose_strip(T, p.in[7] + (size_t)(l * 8 + b) * 256 * 1024, 1024, 0, h * 256 + jt * 64, nullptr, dst, 256, jt * 64, true, false);
    }
    for (int it = bid; it < MROWS_A / 8; it += G) {
        const int row = it * 8 + wid;
        const float* src = row < MP ? p.in[0] + (size_t)row * 1024 : row < MT ? p.in[1] + (size_t)(row - MP) * 1024 : p.in[2] + (size_t)(row - MT) * 1024;
        bf16_t* dst = (bf16_t*)(dout + DO_A1) + (size_t)row * 1024;
        float ss = 0.f; f32x4 vv[4];
#pragma unroll
        for (int i = 0; i < 4; ++i) {
            vv[i] = *(const f32x4*)(src + (lane + 64 * i) * 4);
            ss += vv[i][0] * vv[i][0] + vv[i][1] * vv[i][1] + vv[i][2] * vv[i][2] + vv[i][3] * vv[i][3];
        }
#pragma unroll
        for (int o = 32; o >= 1; o >>= 1) ss += __shfl_xor(ss, o);
        const float rs0 = __builtin_amdgcn_rsqf(ss * (1.0f / 1024.0f) + EPSF);
#pragma unroll
        for (int i = 0; i < 4; ++i) {
            u32x2 w; w.x = cvt_pk_bf16(vv[i][0] * rs0, vv[i][1] * rs0); w.y = cvt_pk_bf16(vv[i][2] * rs0, vv[i][3] * rs0);
            *(u32x2*)(dst + (lane + 64 * i) * 4) = w;
        }
        float* rowss = (float*)(p.ws + WS_ROWSS);
        if (lane == 0) { rowss[row] = ss; rowss[MROWS_A + row] = 0.f; rowss[2 * MROWS_A + row] = 0.f; }
    }
    for (int it = bid; it < 128; it += G) {
        const int l = it >> 6, b = (it >> 3) & 7, kb = it & 7;
        const float* src = p.in[6] + ((size_t)(l * 8 + b) * 256 + kb * 32) * 1024;
        bf16_t* dst = (bf16_t*)(l ? p.ws + WS_KV : dout + DO_KV) + (size_t)(1 + b) * 524288;
#pragma unroll
        for (int i = 0; i < 8; ++i) {
            const int e = (i * 512 + tid) * 8, key = kb * 32 + (e >> 10), c = e & 1023, h = c >> 8, d = c & 255;
            const f32x4 v0 = *(const f32x4*)(src + e), v1 = *(const f32x4*)(src + e + 4);
            u32x4 w; w.x = cvt_pk_bf16(v0[0], v0[1]); w.y = cvt_pk_bf16(v0[2], v0[3]); w.z = cvt_pk_bf16(v1[0], v1[1]); w.w = cvt_pk_bf16(v1[2], v1[3]);
            *(u32x4*)(dst + (size_t)h * 131072 + key * 256 + d) = w;
        }
    }
    for (int it = bid; it < 16; it += G) {
        const int ch = it * 512 + tid, l = ch >> 12, gn = ch & 4095, g = gn >> 6, n = gn & 63;
        unsigned char* par = p.ws + WS_PAR + (size_t)l * PAR_STRIDE;
        const double dt = d_exp((double)p.in[14][l * 64 + g]);
        const double lre = (double)p.in[12][l * 4096 + gn], lim = (double)p.in[13][l * 4096 + gn];
        double s, c; d_sincos(lim * dt, s, c);
        const double mag = d_exp(lre * dt);
        double pr = mag * c, pi = mag * s;
        ((float*)(par + PAR_L1))[gn * 2] = (float)pr; ((float*)(par + PAR_L1))[gn * 2 + 1] = (float)pi;
        const double den = lre * lre + lim * lim, nr = pr - 1.0, ni = pi;
        const double cr = (nr * lre + ni * lim) / den, ci = (ni * lre - nr * lim) / den;
        double qr = pr, qi = pi;
#pragma unroll 1
        for (int k = 0; k < 6; ++k) { const double t = qr * qr - qi * qi; qi = 2.0 * qr * qi; qr = t; }
        ((float*)(par + PAR_L64))[gn * 2] = (float)qr; ((float*)(par + PAR_L64))[gn * 2 + 1] = (float)qi;
#pragma unroll 1
        for (int k = 0; k < 4; ++k) { const double t = qr * qr - qi * qi; qi = 2.0 * qr * qi; qr = t; }
        ((float*)(par + PAR_L1024))[gn * 2] = (float)qr; ((float*)(par + PAR_L1024))[gn * 2 + 1] = (float)qi;
        const float* bre = p.in[15] + ((size_t)l * 4096 + gn) * 16; const float* bim = p.in[16] + ((size_t)l * 4096 + gn) * 16;
        bf16_t* bb = (bf16_t*)(par + PAR_BB);
#pragma unroll
        for (int i = 0; i < 16; i += 2) {
            const double br0 = bre[i], bi0 = bim[i], br1 = bre[i + 1], bi1 = bim[i + 1];
            *(unsigned*)(bb + (g * 128 + n) * 16 + i) = cvt_pk_bf16((float)(cr * br0 - ci * bi0), (float)(cr * br1 - ci * bi1));
            *(unsigned*)(bb + (g * 128 + 64 + n) * 16 + i) = cvt_pk_bf16((float)(cr * bi0 + ci * br0), (float)(cr * bi1 + ci * br1));
        }
    }
    for (int it = bid; it < 256; it += G) {
        const int e = it * 512 + tid, l = e >> 16, r = e & 65535, g = r >> 10, i = (r >> 6) & 15, n = r & 63;
        bf16_t* cm = (bf16_t*)(p.ws + WS_PAR + (size_t)l * PAR_STRIDE + PAR_CM);
        const float cre = p.in[17][(size_t)l * 65536 + r], cim = p.in[18][(size_t)l * 65536 + r];
        *(unsigned*)(cm + (g * 16 + i) * 128 + 2 * n) = cvt_pk_bf16(cre, -cim);
    }
}

DEVI void attn_item(LAS unsigned char* lds, bf16_t* z6, const bf16_t* kvset, int row0, int nvalid, int h, bool dry) {
    const int tid = fresh_tid(), lane = tid & 63, wid = __builtin_amdgcn_readfirstlane(tid >> 6), fr = lane & 15, q4 = lane >> 4;
    const bool active = wid * 16 < nvalid;
    const int row = row0 + wid * 16 + fr;
    __syncthreads();
    {
        const u32x4* src = (const u32x4*)(kvset + (size_t)h * 131072);
#pragma unroll
        for (int i = 0; i < 16; ++i) { const int idx = i * 512 + tid; *(LAS u32x4*)(lds + (idx >> 5) * 544 + (idx & 31) * 16) = src[idx]; }
    }
    bf16x8 qf[8];
    if (active) {
#pragma unroll
        for (int ks = 0; ks < 8; ++ks) qf[ks] = *(const bf16x8*)(z6 + (size_t)row * ZP + SL_Q + h * 256 + 32 * ks + 8 * q4);
    }
    __syncthreads();
    unsigned pk[16][2]; float inv = 0.f;
    f32x4 s[16];
    if (active) {
#pragma unroll
        for (int kt = 0; kt < 16; ++kt) s[kt] = (f32x4){0.f, 0.f, 0.f, 0.f};
#define ATT_LD(dst, st) do { _Pragma("unroll") for (int j = 0; j < 8; ++j) dst[j] = *(const LAS bf16x8*)(lds + (16 * (8 * ((st) & 1) + j) + fr) * 544 + (32 * ((st) >> 1) + 8 * q4) * 2); } while (0)
#define ATT_MM_S(src, st) do { _Pragma("unroll") for (int j = 0; j < 8; ++j) s[8 * ((st) & 1) + j] = __builtin_amdgcn_mfma_f32_16x16x32_bf16(src[j], qf[(st) >> 1], s[8 * ((st) & 1) + j], 0, 0, 0); } while (0)
        bf16x8 fa[8], fb[8];
        ATT_LD(fa, 0);
#pragma unroll
        for (int st = 0; st < 16; st += 2) {
            ATT_LD(fb, st + 1); __builtin_amdgcn_sched_barrier(0);
            ATT_MM_S(fa, st); __builtin_amdgcn_sched_barrier(0);
            if (st + 2 < 16) ATT_LD(fa, st + 2);
            __builtin_amdgcn_sched_barrier(0);
            ATT_MM_S(fb, st + 1); __builtin_amdgcn_sched_barrier(0);
        }
    }
    __builtin_amdgcn_sched_barrier(0);
    u32x4 vreg[16];
    {
        const u32x4* src = (const u32x4*)(kvset + (size_t)h * 131072 + 65536);
#pragma unroll
        for (int i = 0; i < 16; ++i) vreg[i] = src[i * 512 + tid];
    }
    if (active) {
        float mx = -3.0e38f;
#pragma unroll
        for (int kt = 0; kt < 16; ++kt)
#pragma unroll
            for (int r = 0; r < 4; ++r) mx = fmaxf(mx, s[kt][r]);
        mx = fmaxf(mx, __shfl_xor(mx, 16)); mx = fmaxf(mx, __shfl_xor(mx, 32));
        float sum = 0.f;
#pragma unroll
        for (int kt = 0; kt < 16; ++kt) {
            float e0 = __expf(s[kt][0] - mx), e1 = __expf(s[kt][1] - mx), e2 = __expf(s[kt][2] - mx), e3 = __expf(s[kt][3] - mx);
            sum += (e0 + e1) + (e2 + e3);
            pk[kt][0] = cvt_pk_bf16(e0, e1); pk[kt][1] = cvt_pk_bf16(e2, e3);
        }
        sum += __shfl_xor(sum, 16); sum += __shfl_xor(sum, 32);
        inv = 1.0f / sum;
    }
    __syncthreads();
#pragma unroll
    for (int i = 0; i < 16; ++i) { const int idx = i * 512 + tid; *(LAS u32x4*)(lds + (idx >> 5) * 544 + (idx & 31) * 16) = vreg[i]; }
    __syncthreads();
    if (active) {
        f32x4 o[16];
#pragma unroll
        for (int dt = 0; dt < 16; ++dt) o[dt] = (f32x4){0.f, 0.f, 0.f, 0.f};
#define ATT_MM_O(src, st) do { u32x4 pw; pw.x = pk[2 * ((st) >> 1)][0]; pw.y = pk[2 * ((st) >> 1)][1]; pw.z = pk[2 * ((st) >> 1) + 1][0]; pw.w = pk[2 * ((st) >> 1) + 1][1]; const bf16x8 pf = __builtin_bit_cast(bf16x8, pw); \
        _Pragma("unroll") for (int j = 0; j < 8; ++j) o[8 * ((st) & 1) + j] = __builtin_amdgcn_mfma_f32_16x16x32_bf16(src[j], pf, o[8 * ((st) & 1) + j], 0, 0, 0); } while (0)
        bf16x8 fa[8], fb[8];
        ATT_LD(fa, 0);
#pragma unroll
        for (int st = 0; st < 16; st += 2) {
            ATT_LD(fb, st + 1); __builtin_amdgcn_sched_barrier(0);
            ATT_MM_O(fa, st); __builtin_amdgcn_sched_barrier(0);
            if (st + 2 < 16) ATT_LD(fa, st + 2);
            __builtin_amdgcn_sched_barrier(0);
            ATT_MM_O(fb, st + 1); __builtin_amdgcn_sched_barrier(0);
        }
#undef ATT_LD
#undef ATT_MM_S
#undef ATT_MM_O
        bf16_t* zr = z6 + (size_t)row * ZP + h * 256 + 4 * q4;
#pragma unroll
        for (int dt = 0; dt < 16; ++dt) {
            const u32x2 gq = *(const u32x2*)(zr + SL_QGS + 16 * dt);
            u32x2 w; w.x = cvt_pk_bf16(o[dt][0] * inv * silu_f(bf_lo(gq.x)), o[dt][1] * inv * silu_f(bf_hi(gq.x))); w.y = cvt_pk_bf16(o[dt][2] * inv * silu_f(bf_lo(gq.y)), o[dt][3] * inv * silu_f(bf_hi(gq.y)));
            if (!dry || inv == 12345.678f) *(u32x2*)(zr + SL_Q + 16 * dt) = w;
        }
    }
}

DEVI void conv_item(bf16_t* z6, int rb, int l, const P& p, bool dry) {
    const int tid = fresh_tid(), cg8 = tid & 127, rs = tid >> 7, c0 = cg8 * 8, r0 = rb * 64 + rs * 16;
    const float* cw = p.in[10] + l * 3072; const float* cbias = p.in[11] + l * 1024;
    float w0[8], w1[8], w2[8], bb[8], u1[8], u2[8];
#pragma unroll
    for (int j = 0; j < 8; ++j) { w0[j] = cw[c0 + j]; w1[j] = cw[1024 + c0 + j]; w2[j] = cw[2048 + c0 + j]; bb[j] = cbias[c0 + j]; u1[j] = 0.f; u2[j] = 0.f; }
    const bool seq_start = (r0 < MP) ? (r0 == 0) : (((r0 - MP) & 31) == 0);
    if (!seq_start) {
        const u32x4 a = *(const u32x4*)(z6 + (size_t)(r0 - 2) * ZP + SL_U + c0), b = *(const u32x4*)(z6 + (size_t)(r0 - 1) * ZP + SL_U + c0);
#pragma unroll
        for (int j = 0; j < 8; ++j) { u2[j] = (j & 1) ? bf_hi(a[j >> 1]) : bf_lo(a[j >> 1]); u1[j] = (j & 1) ? bf_hi(b[j >> 1]) : bf_lo(b[j >> 1]); }
    } else if (r0 >= MP) {
        const float* cc = p.in[3] + ((size_t)(l * 8 + ((r0 - MP) >> 5)) * 2) * 1024 + c0;
#pragma unroll
        for (int j = 0; j < 8; ++j) { u2[j] = cc[j]; u1[j] = cc[1024 + j]; }
    }
#pragma unroll 1
    for (int tb = 0; tb < 16; tb += 8) {
    u32x4 uwa[8], gwa[8];
#pragma unroll
    for (int t8 = 0; t8 < 8; ++t8) { const bf16_t* zq = z6 + (size_t)(r0 + tb + t8) * ZP + c0; uwa[t8] = *(const u32x4*)(zq + SL_U); gwa[t8] = *(const u32x4*)(zq + SL_GC); }
#pragma unroll
    for (int t8 = 0; t8 < 8; ++t8) {
        const int row = r0 + tb + t8;
        bf16_t* zr = z6 + (size_t)row * ZP + c0;
        const u32x4 uw = uwa[t8], gw = gwa[t8];
        float v[8], u0[8];
#pragma unroll
        for (int j = 0; j < 8; ++j) {
            u0[j] = (j & 1) ? bf_hi(uw[j >> 1]) : bf_lo(uw[j >> 1]);
            const float g = (j & 1) ? bf_hi(gw[j >> 1]) : bf_lo(gw[j >> 1]);
            v[j] = g * (w0[j] * u2[j] + w1[j] * u1[j] + w2[j] * u0[j] + bb[j]);
            u2[j] = u1[j]; u1[j] = u0[j];
        }
        if (!dry || bb[0] == 12345.678f) *(u32x4*)(zr + SL_GC) = pack8(v);
        int so = -1;
        if (row == MP - 2 || row == MP - 1) so = (int)O_PCONV + (l * 2 + (row - (MP - 2))) * 1024;
        else if (row >= MP && ((row - MP) & 31) >= 30) so = (int)O_SCONV + ((l * 8 + ((row - MP) >> 5)) * 2 + (((row - MP) & 31) - 30)) * 1024;
        if (so >= 0) { float* o = p.out + so + c0; *(f32x4*)o = (f32x4){u0[0], u0[1], u0[2], u0[3]}; *(f32x4*)(o + 4) = (f32x4){u0[4], u0[5], u0[6], u0[7]}; }
    }
    }
}

template <int MODE>
DEVI void ssm_wave_item(LAS unsigned char* img, bf16_t* z6, int wi, int l, const P& p, int oslot = 0) {
    const int lane = fresh_tid() & 63, half = lane >> 5, c31 = lane & 31;
    const int pi = wi >> 6, g = wi & 63;
    const bool samp = pi >= 128;
    const int NS = samp ? 2 : 4;
    int rb0, rb1;
    if (!samp) { rb0 = 128 * pi; rb1 = rb0 + 64; } else { rb0 = MP + 64 * (pi - 128); rb1 = rb0 + 32; }
    const unsigned char* par = p.ws + WS_PAR + (size_t)l * PAR_STRIDE;
    const int rho = c31, hrho = (rho >> 2) & 1, rr = (rho & 3) + 4 * (rho >> 3), kh = half;
    const bf16_t* arow = z6 + (size_t)((hrho ? rb1 : rb0) + rr) * ZP + SL_SU + 16 * g + 8 * kh;
    bf16x8 bbf[4];
#pragma unroll
    for (int nt = 0; nt < 4; ++nt) bbf[nt] = *(const bf16x8*)((const bf16_t*)(par + PAR_BB) + (g * 128 + 32 * nt + c31) * 16 + 8 * kh);
    float lre[2], lim[2], hre[2], him[2];
#pragma unroll
    for (int q = 0; q < 2; ++q) {
        const int n = 32 * q + c31;
        const float* L1 = (const float*)(par + PAR_L1) + (g * 64 + n) * 2; lre[q] = L1[0]; lim[q] = L1[1];
        hre[q] = 0.f; him[q] = 0.f;
    }
    const int myrb = half ? rb1 : rb0;
    bf16x8 cmf[4]; float dv[4];
    if (MODE == 1) {
#pragma unroll
        for (int q = 0; q < 2; ++q) {
            const int n = 32 * q + c31;
            if (!samp) { const float* E = (const float*)(p.ws + WS_E) + (size_t)(2 * pi + half) * 8192 + g * 128; hre[q] = E[n]; him[q] = E[64 + n]; }
            else { const int b = 2 * (pi - 128) + half; hre[q] = p.in[4][((size_t)(l * 8 + b) * 64 + g) * 64 + n]; him[q] = p.in[5][((size_t)(l * 8 + b) * 64 + g) * 64 + n]; }
        }
#pragma unroll
        for (int ks = 0; ks < 4; ++ks) cmf[ks] = *(const bf16x8*)((const bf16_t*)(par + PAR_CM) + (g * 16 + (lane & 15)) * 128 + 32 * ks + 8 * (lane >> 4));
#pragma unroll
        for (int r = 0; r < 4; ++r) dv[r] = p.in[19][l * 1024 + 16 * g + 4 * (lane >> 4) + r];
    }
    bf16x8 afs[4]; u32x2 uws[4][2], sgs[4][2];
#pragma unroll
    for (int s = 0; s < 4; ++s) if (s < NS) {
        afs[s] = *(const bf16x8*)(arow + (size_t)(16 * s) * ZP);
        if (MODE == 1) {
#pragma unroll
            for (int ct = 0; ct < 2; ++ct) {
                const bf16_t* zq = z6 + (size_t)((ct ? rb1 : rb0) + 16 * s + (lane & 15)) * ZP + 16 * g + 4 * (lane >> 4);
                uws[s][ct] = *(const u32x2*)(zq + SL_SU); sgs[s][ct] = *(const u32x2*)(zq + SL_SGS);
            }
        }
    }
#pragma unroll
    for (int s = 0; s < 4; ++s) if (s < NS) {
        const bf16x8 af = afs[s];
        f32x16 d[4];
#pragma unroll
        for (int nt = 0; nt < 4; ++nt) {
            f32x16 z;
#pragma unroll
            for (int r = 0; r < 16; ++r) z[r] = 0.f;
            d[nt] = __builtin_amdgcn_mfma_f32_32x32x16_bf16(af, bbf[nt], z, 0, 0, 0);
        }
#pragma unroll
        for (int r = 0; r < 16; ++r) {
            const float nr0 = __builtin_fmaf(-lim[0], him[0], __builtin_fmaf(lre[0], hre[0], d[0][r]));
            const float ni0 = __builtin_fmaf(lim[0], hre[0], __builtin_fmaf(lre[0], him[0], d[2][r]));
            const float nr1 = __builtin_fmaf(-lim[1], him[1], __builtin_fmaf(lre[1], hre[1], d[1][r]));
            const float ni1 = __builtin_fmaf(lim[1], hre[1], __builtin_fmaf(lre[1], him[1], d[3][r]));
            hre[0] = nr0; him[0] = ni0; hre[1] = nr1; him[1] = ni1;
            if (MODE == 1) {
                *(LAS unsigned*)(img + (half * 16 + r) * 288 + 4 * c31) = cvt_pk_bf16(nr0, ni0);
                *(LAS unsigned*)(img + (half * 16 + r) * 288 + 4 * (32 + c31)) = cvt_pk_bf16(nr1, ni1);
            }
        }
        if (MODE == 1) {
            const int t = lane & 15, q4 = lane >> 4;
#pragma unroll
            for (int ct = 0; ct < 2; ++ct) {
                f32x4 y = (f32x4){0.f, 0.f, 0.f, 0.f};
#pragma unroll
                for (int ks = 0; ks < 4; ++ks) {
                    const bf16x8 hf = *(const LAS bf16x8*)(img + (ct * 16 + t) * 288 + (32 * ks + 8 * q4) * 2);
                    y = __builtin_amdgcn_mfma_f32_16x16x32_bf16(cmf[ks], hf, y, 0, 0, 0);
                }
                bf16_t* zp = z6 + (size_t)((ct ? rb1 : rb0) + 16 * s + t) * ZP + SL_SU + 16 * g + 4 * q4;
                const u32x2 uw = uws[s][ct];
                const u32x2 sw = sgs[s][ct];
                const float y0 = gelu_f(y[0] + dv[0] * bf_lo(uw.x)), y1 = gelu_f(y[1] + dv[1] * bf_hi(uw.x)), y2 = gelu_f(y[2] + dv[2] * bf_lo(uw.y)), y3 = gelu_f(y[3] + dv[3] * bf_hi(uw.y));
                u32x2 w; w.x = cvt_pk_bf16(y0, y1); w.y = cvt_pk_bf16(y2, y3);
                *(u32x2*)(zp + oslot) = w;
                u32x2 wg; wg.x = cvt_pk_bf16(y0 * silu_f(bf_lo(sw.x)), y1 * silu_f(bf_hi(sw.x))); wg.y = cvt_pk_bf16(y2 * silu_f(bf_lo(sw.y)), y3 * silu_f(bf_hi(sw.y)));
                *(u32x2*)(zp + (SL_SGS - SL_SU)) = wg;
            }
        }
    }
    (void)myrb;
    if (MODE == 0) {
        float* E = (float*)(p.ws + WS_E) + (size_t)(2 * pi + half) * 8192 + g * 128;
#pragma unroll
        for (int q = 0; q < 2; ++q) { E[32 * q + c31] = hre[q]; E[64 + 32 * q + c31] = him[q]; }
    } else if (samp) {
        const int b = 2 * (pi - 128) + half;
#pragma unroll
        for (int q = 0; q < 2; ++q) {
            const size_t o = ((size_t)(l * 8 + b) * 64 + g) * 64 + 32 * q + c31;
            p.out[O_SRE + o] = hre[q]; p.out[O_SIM + o] = him[q];
        }
    }
}

DEVI void scan_item(LAS unsigned char* lds, int item, int l, const P& p, bool dry = false) {
    const int tid = fresh_tid(), chl = tid & 31, seg = tid >> 5, ch = item * 32 + chl, g = ch >> 6, n = ch & 63;
    const unsigned char* par = p.ws + WS_PAR + (size_t)l * PAR_STRIDE;
    const float ar = ((const float*)(par + PAR_L64))[ch * 2], ai = ((const float*)(par + PAR_L64))[ch * 2 + 1];
    const float br = ((const float*)(par + PAR_L1024))[ch * 2], bi = ((const float*)(par + PAR_L1024))[ch * 2 + 1];
    float* E = (float*)(p.ws + WS_E) + g * 128 + n;
    float er[16], ei[16];
#pragma unroll
    for (int i = 0; i < 16; ++i) { er[i] = E[(size_t)(seg * 16 + i) * 8192]; ei[i] = E[(size_t)(seg * 16 + i) * 8192 + 64]; }
    float hr = 0.f, hi = 0.f;
#pragma unroll
    for (int i = 0; i < 16; ++i) { const float t = ar * hr - ai * hi + er[i]; hi = ar * hi + ai * hr + ei[i]; hr = t; }
    LAS float* se = (LAS float*)lds;
    __syncthreads();
    se[(seg * 32 + chl) * 2] = hr; se[(seg * 32 + chl) * 2 + 1] = hi;
    __syncthreads();
    hr = 0.f; hi = 0.f;
    for (int s2 = 0; s2 < seg; ++s2) { const float xr = se[(s2 * 32 + chl) * 2], xi = se[(s2 * 32 + chl) * 2 + 1]; const float t = br * hr - bi * hi + xr; hi = br * hi + bi * hr + xi; hr = t; }
#pragma unroll
    for (int i = 0; i < 16; ++i) {
        if (!dry || ar == 12345.678f) { E[(size_t)(seg * 16 + i) * 8192] = hr; E[(size_t)(seg * 16 + i) * 8192 + 64] = hi; }
        const float t = ar * hr - ai * hi + er[i]; hi = ar * hi + ai * hr + ei[i]; hr = t;
    }
    if (seg == 15) { p.out[O_PRE + (size_t)l * 4096 + ch] = hr; p.out[O_PIM + (size_t)l * 4096 + ch] = hi; }
}

__global__ void __launch_bounds__(512, 2) fwd_megakernel(P p) {
    extern __shared__ __attribute__((aligned(16))) unsigned char shm[];
    LAS unsigned char* lds = (LAS unsigned char*)shm;
    cg::grid_group grid = cg::this_grid();
    const int G = gridDim.x, bid = blockIdx.x;
    unsigned char* dout = (unsigned char*)p.out;
    bf16_t* z6 = (bf16_t*)(p.ws + WS_Z6);
    float* rowss = (float*)(p.ws + WS_ROWSS);

    if (threadIdx.x < 4) ((LAS unsigned*)(lds + 139264))[threadIdx.x] = 0u;
    __syncthreads();
    const XcdBarrier xbar = xcd_barrier_post((unsigned*)(p.ws + WS_BAR), (volatile LAS unsigned*)(lds + 139264));
    phase0(p, lds);
    if (p.ws == nullptr) grid.sync();
    xcd_barrier(xbar);
    for (int rep = 0; rep < EXTRA_SYNC; ++rep) xcd_barrier(xbar);

    constexpr int NSB = 48, NPB = 208;
    unsigned* sctr = (unsigned*)(p.ws + WS_CTR);
    float* slab = (float*)(p.ws + WS_SLAB);
    unsigned sep = 0;
#pragma unroll 1
    for (int l = 0; l < 2; ++l) {
        const bf16_t* kvl = (const bf16_t*)(l ? p.ws + WS_KV : dout + DO_KV);
        const char* A1 = (const char*)(dout + (l ? DO_HI : DO_A1));
        const int lda1 = l ? 2048 : 1024;
        const char* W1 = (const char*)(l ? p.ws + WS_WT1 : dout + DO_WT1);
        const char* W2 = (const char*)(l ? p.ws + WS_WT2 : dout + DO_WT2);
        const char* W3 = (const char*)(p.ws + WS_WT3 + (size_t)l * WT3_STRIDE);
        {
            g8::Sched S{}; S.mode = 0; S.nM = 64; S.nN = 32; S.nwg = 64 * 32; S.G = G; S.c = bid; S.nextra = 0;
            S.A = A1; S.B = W1; S.tA = (size_t)256 * lda1 * 2; S.tB = (size_t)256 * 1024 * 2;
            Epi1 E{z6, l ? rowss + MROWS_A : (const float*)nullptr, rowss + MT, p.out, (bf16_t*)(dout + DO_KV), (bf16_t*)(p.ws + WS_KV)};
            g8::gemm_phase<Epi1>(lds, 1024, lda1, 1024, S, E);
        }
        xcd_barrier(xbar);
        const int nsb = l ? 32 : NSB, npb = 256 - nsb;
        if (bid < nsb) {
            if (l == 1) {
                const int widf = __builtin_amdgcn_readfirstlane(fresh_tid() >> 6);
                finalize_sample(bid * 8 + widf, 0, p, slab, rowss + MROWS_A);
                group_barrier(sctr + 2, 32u);
            }
            g8::Sched S{}; S.mode = 1; S.nM = 1; S.nN = 32; S.nwg = 32; S.G = NSB; S.c = bid; S.nextra = (l == 0) ? 16 : 0;
            S.A = A1; S.B = W1; S.tA = (size_t)256 * lda1 * 2; S.tB = (size_t)256 * 1024 * 2;
            S.Ax = (const char*)(dout + DO_A1) + (size_t)65 * 256 * 1024 * 2; S.Bx0 = (const char*)(dout + DO_WT1); S.Bx1 = (const char*)(p.ws + WS_WT1);
            Epi1 E{z6, l ? rowss + MROWS_A : (const float*)nullptr, rowss + MT, p.out, (bf16_t*)(dout + DO_KV), (bf16_t*)(p.ws + WS_KV)};
            g8::gemm_phase<Epi1>(lds, 1024, lda1, 1024, S, E);
        } else {
            const int pb = bid - nsb;
            for (int it = pb; it < 256; it += npb) conv_item(z6, it, l, p, false);
            const int wid = __builtin_amdgcn_readfirstlane(fresh_tid() >> 6);
            for (int it = (pb + npb - (l ? 32 : 48)) % npb; it < 1024; it += npb) ssm_wave_item<0>(lds, z6, it * 8 + wid, l, p);
            if (l == 0) for (int it = pb; it < 352; it += npb) weight_strip(p, (LAS float*)lds, 1, it);
            else if (pb < NPB) attn_item(lds, z6, kvl, (pb >> 2) * 128, 128, pb & 3, false);
        }
        xcd_barrier(xbar);
        if (bid < NSB) {
            for (int it = bid; it < 32; it += NSB) attn_item(lds, z6, kvl + (size_t)(1 + (it >> 2)) * 524288, MP + 32 * (it >> 2), 32, it & 3, false);
            if (bid >= 32 && bid < 36) conv_item(z6, 256 + bid - 32, l, p, false);
            __syncthreads();
            const int wid = __builtin_amdgcn_readfirstlane(fresh_tid() >> 6);
            if (bid >= 32) for (int it = 1024 + (bid - 32); it < 1056; it += 16) ssm_wave_item<1>(lds + wid * 9216, z6, it * 8 + wid, l, p, 0);
        } else {
            for (int rep = 0; rep < REP_SCAN; ++rep) for (int it = bid - NSB; it < 128; it += NPB) scan_item(lds, it, l, p, rep + 1 < REP_SCAN);
            { const int it = (l ? NPB : 0) + bid - NSB; attn_item(lds, z6, kvl, (it >> 2) * 128, 128, it & 3, false); }
            if (l == 0) for (int it = 352 + bid - NSB; it < 768; it += NPB) weight_strip(p, (LAS float*)lds, 1, it < 512 ? it : it + 128);
        }
        xcd_barrier(xbar);
        constexpr int NSD = 20, NPD = 236;
        if (bid < NSD) {
#pragma unroll 1
            for (int batch = 0; batch < 2; ++batch) {
                if (batch == 0) {
                    g8::Sched S{}; S.mode = 2; S.nM = 1; S.nN = 4; S.nwg = 4; S.G = NSB; S.c = bid; S.nextra = 0;
                    S.A = (const char*)(z6 + SL_SU); S.B = W2; S.tA = (size_t)256 * ZP * 2; S.tB = (size_t)256 * 1024 * 2; S.koff = 0; S.kmap = 0u;
                    Epi2 E{z6, p.in[21] + l * 1024, SL_SGS};
                    g8::gemm_phase<Epi2>(lds, 1024, ZP, 1024, S, E);
                }
                {
                    g8::Sched S{}; S.mode = 2; S.nM = 1; S.nN = 4; S.G = NSB; S.nextra = 0;
                    S.nwg = batch ? 8 : 16; S.c = batch ? bid : (bid >= 4 ? bid - 4 : (1 << 20)); S.kmap = batch ? 0x32u : 0x5410u;
                    S.A = (const char*)z6; S.B = W3; S.tA = (size_t)256 * ZP * 2; S.tB = (size_t)256 * 3072 * 2; S.koff = 1024;
                    Epi3s E{slab};
                    g8::gemm_phase<Epi3s>(lds, 512, ZP, 3072, S, E);
                }
                if (batch == 0) group_barrier(sctr + 1, NSD * (unsigned)(l + 1));
            }
        } else {
            const int pb = bid - NSD;
            __syncthreads();
            const int wid = __builtin_amdgcn_readfirstlane(fresh_tid() >> 6);
            const int a0 = l ? 2 * NPB : NPB, nH = l ? 96 : 68;
            const int q = pb;
            if (q < nH) { for (int it = q; it < 3 * nH; it += nH) ssm_wave_item<1>(lds + wid * 9216, z6, it * 8 + wid, l, p, 0); }
            else { for (int it = 3 * nH + (q - nH); it < 1024; it += NPD - nH) ssm_wave_item<1>(lds + wid * 9216, z6, it * 8 + wid, l, p, 0); }
            if (l == 0) { attn_item(lds, z6, kvl, ((a0 + q) >> 2) * 128, 128, (a0 + q) & 3, false); if (q < nH) { const int ia = a0 + NPD + q; attn_item(lds, z6, kvl, (ia >> 2) * 128, 128, ia & 3, false); } }
            else if (q < nH) { const int ia = a0 + q; attn_item(lds, z6, kvl, (ia >> 2) * 128, 128, ia & 3, false); }
        }
        xcd_barrier(xbar);
        {
            g8::Sched S{}; S.mode = 0; S.nM = 64; S.nN = 4; S.nwg = 256; S.G = G; S.c = bid; S.nextra = 0;
            S.A = (const char*)(z6 + SL_SU); S.B = W2; S.tA = (size_t)256 * ZP * 2; S.tB = (size_t)256 * 1024 * 2;
            Epi2 E{z6, p.in[21] + l * 1024, SL_SGS};
            g8::gemm_phase<Epi2>(lds, 1024, ZP, 1024, S, E);
        }
        xcd_barrier(xbar);
        {
            g8::Sched S{}; S.mode = 0; S.nM = 64; S.nN = 4; S.nwg = 256; S.G = G; S.c = bid; S.nextra = 0;
            S.A = (const char*)z6; S.B = W3; S.tA = (size_t)256 * ZP * 2; S.tB = (size_t)256 * 3072 * 2;
            Epi3 E{l, p.in[0], dout, rowss + (l + 1) * MROWS_A, (unsigned*)(p.ws + WS_CTR) + 64, p.in[25]};
            g8::gemm_phase<Epi3>(lds, 3072, ZP, 3072, S, E);
        }
        if (l == 0) xcd_barrier(xbar);
    }
    if (bid < 32) {
        const int widf = __builtin_amdgcn_readfirstlane(fresh_tid() >> 6);
        finalize_sample(bid * 8 + widf, 1, p, slab, rowss);
    }
}

extern "C" void kernel_launch(void* const* d_in, const int* in_sizes, int n_in, void* d_out, int out_size, void* d_ws, size_t ws_size, hipStream_t stream) {
    static int grid_blocks = 0;
    if (!grid_blocks) {
        if (n_in != 26 || ws_size < WS_END || out_size != 18272256) { fprintf(stderr, "kernel_launch: unexpected shapes (n_in %d ws %zu out %d)\n", n_in, ws_size, out_size); grid_blocks = -1; return; }
        int dev = 0, cus = 0, per_cu = 0;
        hipGetDevice(&dev);
        hipDeviceGetAttribute(&cus, hipDeviceAttributeMultiprocessorCount, dev);
        if (hipFuncSetAttribute((const void*)fwd_megakernel, hipFuncAttributeMaxDynamicSharedMemorySize, LDS_BYTES) != hipSuccess) { fprintf(stderr, "kernel_launch: hipFuncSetAttribute failed\n"); grid_blocks = -1; return; }
        hipOccupancyMaxActiveBlocksPerMultiprocessor(&per_cu, (const void*)fwd_megakernel, 512, LDS_BYTES);
        if (per_cu < 1) { fprintf(stderr, "kernel_launch: occupancy query says %d blocks/CU\n", per_cu); per_cu = 1; }
        (void)hipGetLastError();
        if (cus < 256) { fprintf(stderr, "kernel_launch: this kernel's static phase partitions need 256 co-resident blocks (device has %d CUs)\n", cus); grid_blocks = -1; return; }
        grid_blocks = 256;
    }
    if (grid_blocks < 0) return;
    if (hipMemsetAsync((char*)d_ws + WS_CTR, 0, WS_END - WS_CTR, stream) != hipSuccess) { fprintf(stderr, "kernel_launch: hipMemsetAsync failed\n"); return; }
    P p{};
    for (int i = 0; i < 26; ++i) p.in[i] = (const float*)d_in[i];
    p.out = (float*)d_out; p.ws = (unsigned char*)d_ws;
    void* args[] = {&p};
    hipError_t e = hipLaunchCooperativeKernel((void*)fwd_megakernel, dim3(grid_blocks), dim3(512), args, LDS_BYTES, stream);
    if (e != hipSuccess) fprintf(stderr, "cooperative launch failed: %s (grid %d)\n", hipGetErrorString(e), grid_blocks);
}
```

```cpp
#include <hip/hip_runtime.h>
#include <hip/hip_cooperative_groups.h>
#include <cstdio>
namespace cg = cooperative_groups;

#define LAS __attribute__((address_space(3)))
#define DEVI __device__ __forceinline__
typedef unsigned short bf16_t;
typedef short bf16x8 __attribute__((ext_vector_type(8)));
typedef float f32x4 __attribute__((ext_vector_type(4)));
typedef float f32x16 __attribute__((ext_vector_type(16)));
typedef unsigned u32x4 __attribute__((ext_vector_type(4)));
typedef unsigned u32x2 __attribute__((ext_vector_type(2)));

constexpr int MP = 16384, MT = 16640, MROWS_A = 16896;
constexpr int ZP = 6144;
constexpr int SL_GC = 0, SL_SGS = 1024, SL_Q = 2048, SL_U = 3072, SL_SU = 4096, SL_QGS = 5120;
constexpr float EPSF = 1e-6f;
constexpr int LDS_BYTES = 139264 + 16;
constexpr size_t O_PCONV = 17039360, O_PRE = 17043456, O_PIM = 17051648, O_PK = 17059840, O_PV = 17584128, O_SCONV = 18108416, O_SRE = 18141184, O_SIM = 18206720;
constexpr size_t DO_A1 = 0, DO_WT1 = 34603008, DO_WT2 = 55574528, DO_KV = 57671680;
constexpr size_t DO_HI = 0, DO_LO = 2048, HL_PITCH = 4096;
constexpr size_t WS_Z6 = 0, WS_WT1 = 204472320, WS_WT2 = 225443840, WS_WT3 = 227540992, WS_KV = 240123904, WS_E = 249561088, WS_PAR = 257949696, WS_ROWSS = 259194880, WS_SLAB = 259397632, WS_CTR = 265689088, WS_BAR = 265690112, WS_END = 265703936;
constexpr size_t PAR_L1 = 0, PAR_L64 = 32768, PAR_L1024 = 65536, PAR_BB = 98304, PAR_CM = 360448, PAR_STRIDE = 622592;
constexpr size_t WT3_STRIDE = 6291456;

#ifndef REP_P0
#define REP_P0 1
#endif
#ifndef REP_G1
#define REP_G1 1
#endif
#ifndef REP_S1
#define REP_S1 1
#endif
#ifndef EXTRA_SYNC
#define EXTRA_SYNC 0
#endif
#ifndef REP_SCAN
#define REP_SCAN 1
#endif
#ifndef REP_MIX
#define REP_MIX 1
#endif
#ifndef REP_S3
#define REP_S3 1
#endif
#ifndef REP_G23
#define REP_G23 1
#endif
struct P { const float* in[26]; float* out; unsigned char* ws; };

DEVI int fresh_tid() { int t = threadIdx.x; asm volatile("" : "+v"(t)); return t; }
DEVI unsigned cvt_pk_bf16(float lo, float hi) { unsigned r; asm("v_cvt_pk_bf16_f32 %0, %1, %2" : "=v"(r) : "v"(lo), "v"(hi)); return r; }
DEVI float bf_lo(unsigned w) { return __uint_as_float(w << 16); }
DEVI float bf_hi(unsigned w) { return __uint_as_float(w & 0xffff0000u); }
DEVI float sigm_f(float x) { return __builtin_amdgcn_rcpf(1.0f + __expf(-x)); }
DEVI float silu_f(float x) { return x * sigm_f(x); }
DEVI float gelu_f(float x) { return x * sigm_f(1.5957691216057308f * (x + 0.044715f * x * x * x)); }

namespace g8 {
constexpr int BM = 256, BK = 64, HALF = 128, HTB = HALF * BK * 2, NXCD = 8, WGM = 4;
DEVI int lds_byte(int r, int c) { const int st = (r >> 4) * 2 + (c >> 5), rr = r & 15, cc = c & 31, ob = rr * 64 + cc * 2; return st * 1024 + (ob ^ (((ob >> 9) & 1) << 5)); }
DEVI void stage_rc(int b, int& R, int& C) { const int st = b / 1024, sb = b % 1024, swz = sb ^ (((sb >> 9) & 1) << 5); R = (st >> 1) * 16 + swz / 64; C = (st & 1) * 32 + (swz % 64) / 2; }

struct GUnit { const char* a; const char* b; int pm, pn, kind, lay; };

struct Sched {
    int mode;
    int nM, nN, nwg, G, c, nextra;
    const char* A; const char* B; size_t tA, tB, koff;
    const char* Ax; const char* Bx0; const char* Bx1;
    unsigned kmap;
    DEVI bool next(int i, GUnit& u) const {
        const int L = i * G + c;
        if (L >= nwg + nextra) return false;
        if (mode == 0) {
            int wgid = L; { const int q = nwg / NXCD, r = nwg % NXCD, xcd = wgid % NXCD, off = wgid / NXCD; wgid = (xcd < r ? xcd * (q + 1) : r * (q + 1) + (xcd - r) * q) + off; }
            const int nig = WGM * nN, gid = wgid / nig, fm = gid * WGM, gsz = (nM - fm) < WGM ? (nM - fm) : WGM;
            u.pm = fm + ((wgid % nig) % gsz); u.pn = (wgid % nig) / gsz; u.kind = 0; u.lay = 0;
            u.a = A + (size_t)u.pm * tA; u.b = B + (size_t)u.pn * tB;
        } else if (mode == 1) {
            if (L < nwg) { u.pm = 64; u.pn = L; u.kind = 0; u.lay = 0; u.a = A + (size_t)64 * tA; u.b = B + (size_t)L * tB; }
            else { const int x = L - nwg; u.lay = x >> 3; u.pn = x & 7; u.pm = 65; u.kind = 1; u.a = Ax; u.b = (u.lay ? Bx1 : Bx0) + (size_t)(32 + u.pn) * tB; }
        } else {
            u.pm = 64; u.pn = L % nN; u.lay = (int)((kmap >> (4 * (L / nN))) & 15u); u.kind = 0;
            u.a = A + (size_t)64 * tA + (size_t)u.lay * koff; u.b = B + (size_t)u.pn * tB + (size_t)u.lay * koff;
        }
        return true;
    }
};

template <class T, class = void> struct after_drain_t { static constexpr bool value = false; };
template <class T> struct after_drain_t<T, decltype((void)T::AFTER_DRAIN)> { static constexpr bool value = T::AFTER_DRAIN; };
template <class T> constexpr bool after_drain_v = after_drain_t<T>::value;
template <class Epi>
DEVI void gemm_phase(LAS unsigned char* lds, const int K, const int lda, const int ldb, const Sched& S, const Epi& E) {
    const int tid = fresh_tid(), wid = __builtin_amdgcn_readfirstlane(tid >> 6), lane = tid & 63, wr = wid >> 2, wc = wid & 3, fr = lane & 15, fq = lane >> 4;
    const int nt = K / BK;
    unsigned voffA[2], voffB[2];
#pragma unroll
    for (int i = 0; i < 2; ++i) { int R, C; stage_rc(tid * 16 + i * 8192, R, C); voffA[i] = (unsigned)(R * lda + C) * 2u; voffB[i] = (unsigned)(R * ldb + C) * 2u; }
    const size_t kstep = (size_t)(BK * 2);
    const size_t hA = (size_t)HALF * lda * 2, hB = (size_t)HALF * ldb * 2;
    const unsigned ldsw = (unsigned)wid * 1024u;
    const int aoff = lds_byte(wr * 64 + fr, fq * 8), boff = lds_byte(wc * 32 + fr, fq * 8);
#define PG8_SA(b, h) (((b) * 2 + (h)) * HTB)
#define PG8_SB(b, h) ((4 + (b) * 2 + (h)) * HTB)
#define PG8_STAGE(bufoff, gbase, voff) do { _Pragma("unroll") for (int _i = 0; _i < 2; ++_i) \
        __builtin_amdgcn_global_load_lds((const unsigned*)((const char*)(gbase) + (voff)[_i]), (LAS unsigned*)(lds + (bufoff) + ldsw + _i * 8192), 16, 0, 0); } while (0)
#define PG8_LDA(dst, b, h) do { _Pragma("unroll") for (int m = 0; m < 4; ++m) _Pragma("unroll") for (int k = 0; k < 2; ++k) dst[m][k] = *(const LAS bf16x8*)(lds + PG8_SA(b, h) + aoff + m * 2048 + k * 1024); } while (0)
#define PG8_LDB(dst, b, h) do { _Pragma("unroll") for (int n = 0; n < 2; ++n) _Pragma("unroll") for (int k = 0; k < 2; ++k) dst[n][k] = *(const LAS bf16x8*)(lds + PG8_SB(b, h) + boff + n * 2048 + k * 1024); } while (0)
#define PG8_MMA(ai, bj, At, Bt) do { __builtin_amdgcn_s_setprio(1); _Pragma("unroll") for (int m = 0; m < 4; ++m) _Pragma("unroll") for (int n = 0; n < 2; ++n) _Pragma("unroll") for (int k = 0; k < 2; ++k) \
        acc[ai][bj][m][n] = __builtin_amdgcn_mfma_f32_16x16x32_bf16(Bt[n][k], At[m][k], acc[ai][bj][m][n], 0, 0, 0); __builtin_amdgcn_s_setprio(0); } while (0)
#define PG8_WAIT_V(n) asm volatile("s_waitcnt vmcnt(" #n ")" ::: "memory")
#define PG8_WAIT_L(n) asm volatile("s_waitcnt lgkmcnt(" #n ")" ::: "memory")
#define PG8_BAR __builtin_amdgcn_s_barrier()
#define PG8_SCHED __builtin_amdgcn_sched_barrier(0)
    GUnit cur, nxt; int ui = 0;
    if (!S.next(0, cur)) return;
    f32x4 acc[2][2][4][2];
#pragma unroll
    for (int a = 0; a < 2; ++a)
#pragma unroll
        for (int b = 0; b < 2; ++b)
#pragma unroll
            for (int m = 0; m < 4; ++m)
#pragma unroll
                for (int n = 0; n < 2; ++n) acc[a][b][m][n] = (f32x4){0.f, 0.f, 0.f, 0.f};
    bf16x8 At[4][2], B0[2][2], B1[2][2];
    const char* cA = cur.a; const char* cB = cur.b;
    PG8_STAGE(PG8_SB(0, 0), cB, voffB); PG8_STAGE(PG8_SA(0, 0), cA, voffA); PG8_STAGE(PG8_SB(0, 1), cB + hB, voffB); PG8_STAGE(PG8_SA(0, 1), cA + hA, voffA);
    if (wr == 1) PG8_BAR;
    PG8_WAIT_V(4); PG8_BAR;
    PG8_STAGE(PG8_SB(1, 0), cB + kstep, voffB); PG8_STAGE(PG8_SA(1, 0), cA + kstep, voffA); PG8_STAGE(PG8_SB(1, 1), cB + hB + kstep, voffB);
    PG8_WAIT_V(6); PG8_BAR;
    for (;;) {
        const bool has_next = S.next(ui + 1, nxt);
        const char* nA = has_next ? nxt.a : cA; const char* nB = has_next ? nxt.b : cB;
        for (int t = 0; t < nt; t += 2) {
            const bool last = (t == nt - 2);
            const char* a1 = cA + (size_t)(t + 1) * kstep;
            const char* a2 = last ? nA : cA + (size_t)(t + 2) * kstep; const char* b2 = last ? nB : cB + (size_t)(t + 2) * kstep;
            const char* a3 = a2 + kstep; const char* b3 = b2 + kstep;
            PG8_LDB(B0, 0, 0); PG8_SCHED; PG8_LDA(At, 0, 0); PG8_STAGE(PG8_SA(1, 1), a1 + hA, voffA);
            PG8_WAIT_L(8); PG8_BAR; PG8_WAIT_L(0); PG8_MMA(0, 0, At, B0); PG8_BAR; PG8_SCHED;
            PG8_LDB(B1, 0, 1); PG8_STAGE(PG8_SB(0, 0), b2, voffB);
            PG8_BAR; PG8_WAIT_L(0); PG8_MMA(0, 1, At, B1); PG8_BAR;
            PG8_LDA(At, 0, 1); PG8_STAGE(PG8_SA(0, 0), a2, voffA);
            PG8_BAR; PG8_WAIT_L(0); PG8_MMA(1, 0, At, B0); PG8_BAR; PG8_SCHED;
            PG8_STAGE(PG8_SB(0, 1), b2 + hB, voffB);
            PG8_WAIT_V(6); PG8_BAR; PG8_MMA(1, 1, At, B1); PG8_BAR;
            PG8_LDB(B0, 1, 0); PG8_SCHED; PG8_LDA(At, 1, 0); PG8_STAGE(PG8_SA(0, 1), a2 + hA, voffA);
            PG8_WAIT_L(8); PG8_BAR; PG8_WAIT_L(0); PG8_MMA(0, 0, At, B0); PG8_BAR; PG8_SCHED;
            PG8_LDB(B1, 1, 1); PG8_STAGE(PG8_SB(1, 0), b3, voffB);
            PG8_BAR; PG8_WAIT_L(0); PG8_MMA(0, 1, At, B1); PG8_BAR;
            PG8_LDA(At, 1, 1); PG8_STAGE(PG8_SA(1, 0), a3, voffA);
            PG8_BAR; PG8_WAIT_L(0); PG8_MMA(1, 0, At, B0); PG8_BAR; PG8_SCHED;
            PG8_STAGE(PG8_SB(1, 1), b3 + hB, voffB);
            PG8_WAIT_V(6); PG8_BAR; PG8_MMA(1, 1, At, B1); PG8_BAR;
        }
        if constexpr (!after_drain_v<Epi>) E(acc, cur, wr, wc, fr, fq);
        if (!has_next) break;
#pragma unroll
        for (int a = 0; a < 2; ++a)
#pragma unroll
            for (int b = 0; b < 2; ++b)
#pragma unroll
                for (int m = 0; m < 4; ++m)
#pragma unroll
                    for (int n = 0; n < 2; ++n) acc[a][b][m][n] = (f32x4){0.f, 0.f, 0.f, 0.f};
        cur = nxt; cA = nA; cB = nB; ++ui;
    }
    PG8_WAIT_V(0);
    if (wr == 0) PG8_BAR;
    PG8_BAR;
    if constexpr (after_drain_v<Epi>) E.fused(acc, cur, wr, wc, fr, fq);
#undef PG8_SA
#undef PG8_SB
#undef PG8_STAGE
#undef PG8_LDA
#undef PG8_LDB
#undef PG8_MMA
#undef PG8_WAIT_V
#undef PG8_WAIT_L
#undef PG8_BAR
#undef PG8_SCHED
}
}

DEVI u32x4 pack8(const float (&v)[8]) { u32x4 w; w.x = cvt_pk_bf16(v[0], v[1]); w.y = cvt_pk_bf16(v[2], v[3]); w.z = cvt_pk_bf16(v[4], v[5]); w.w = cvt_pk_bf16(v[6], v[7]); return w; }

struct Epi1 {
    bf16_t* z6; const float* rowss; const float* rowss_mem; float* out; bf16_t* kv0; bf16_t* kv1;
    DEVI void operator()(const f32x4 (&acc)[2][2][4][2], const g8::GUnit& u, int wr, int wc, int fr, int fq) const {
        asm volatile("" : "+v"(fr), "+v"(fq));
        if (u.kind == 0) {
            const int pn = u.pn;
#pragma unroll
            for (int ai = 0; ai < 2; ++ai)
#pragma unroll
                for (int m = 0; m < 4; ++m) {
                    const int row = u.pm * 256 + ai * 128 + wr * 64 + m * 16 + fr;
                    const float rs = rowss ? __builtin_amdgcn_rsqf(rowss[row] * (1.0f / 1024.0f) + EPSF) : 1.0f;
                    bf16_t* zr = z6 + (size_t)row * ZP + wc * 32 + fq * 8;
                    if (pn < 16) {
                        float v[8];
#pragma unroll
                        for (int n = 0; n < 2; ++n)
#pragma unroll
                            for (int e = 0; e < 4; ++e) { const float a = acc[ai][0][m][n][e] * rs, b = acc[ai][1][m][n][e] * rs; v[4 * n + e] = (pn < 8) ? a * b : a * silu_f(b); }
                        const int col = (pn < 8) ? (SL_U + 128 * pn) : (SL_GC + 128 * (pn - 8));
                        *(u32x4*)(zr + col) = pack8(v);
                    } else {
                        const int part = (pn - 16) >> 2, cb = (pn - 16) & 3;
                        const int slot = part == 0 ? SL_SU : part == 1 ? SL_SGS : part == 2 ? SL_Q : SL_QGS;
#pragma unroll
                        for (int bj = 0; bj < 2; ++bj) {
                            float v[8];
#pragma unroll
                            for (int n = 0; n < 2; ++n)
#pragma unroll
                                for (int e = 0; e < 4; ++e) { const float a = acc[ai][bj][m][n][e] * rs; v[4 * n + e] = (part == 2) ? a * 0.0625f : a; }
                            *(u32x4*)(zr + slot + 256 * cb + 128 * bj) = pack8(v);
                        }
                    }
                    asm volatile("" ::: "memory");
                }
        } else {
            const int lk = u.lay, pnk = u.pn, isv = pnk >> 2, h = pnk & 3;
            bf16_t* kvb = (lk ? kv1 : kv0) + (size_t)h * 131072 + (isv ? 65536 : 0);
            float* o32 = out + (isv ? O_PV : O_PK) + (size_t)lk * 262144 + h * 256;
#pragma unroll
            for (int ai = 0; ai < 2; ++ai)
#pragma unroll
                for (int m = 0; m < 4; ++m) {
                    const int key = ai * 128 + wr * 64 + m * 16 + fr;
                    const float rs = 1.0f;
#pragma unroll
                    for (int bj = 0; bj < 2; ++bj) {
                        const int d0 = 128 * bj + 32 * wc + 8 * fq;
                        float v[8];
#pragma unroll
                        for (int n = 0; n < 2; ++n)
#pragma unroll
                            for (int e = 0; e < 4; ++e) v[4 * n + e] = acc[ai][bj][m][n][e] * rs;
                        *(f32x4*)(o32 + (size_t)key * 1024 + d0) = (f32x4){v[0], v[1], v[2], v[3]};
                        *(f32x4*)(o32 + (size_t)key * 1024 + d0 + 4) = (f32x4){v[4], v[5], v[6], v[7]};
                        if (!isv) *(u32x4*)(kvb + key * 256 + d0) = pack8(v);
                        else {
                            const int k5 = key & 31, slot = (key & ~31) + 8 * ((k5 >> 2) & 3) + 4 * (k5 >> 4) + (k5 & 3);
#pragma unroll
                            for (int j = 0; j < 8; ++j) kvb[(d0 + j) * 256 + slot] = (bf16_t)(cvt_pk_bf16(v[j], 0.f) & 0xffffu);
                        }
                        asm volatile("" ::: "memory");
                    }
                }
        }
    }
};

struct Epi2 {
    bf16_t* z6; const float* glu_b; int oslot;
    DEVI void operator()(const f32x4 (&acc)[2][2][4][2], const g8::GUnit& u, int wr, int wc, int fr, int fq) const {
        asm volatile("" : "+v"(fr), "+v"(fq));
#pragma unroll
        for (int bj = 0; bj < 2; ++bj) {
            const int c0 = u.pn * 256 + 128 * bj + 32 * wc + 8 * fq;
            const f32x4 b0 = *(const f32x4*)(glu_b + c0), b1 = *(const f32x4*)(glu_b + c0 + 4);
            u32x4 sgv[2][4];
#pragma unroll
            for (int ai = 0; ai < 2; ++ai)
#pragma unroll
                for (int m = 0; m < 4; ++m) sgv[ai][m] = *(const u32x4*)(z6 + (size_t)(u.pm * 256 + ai * 128 + wr * 64 + m * 16 + fr) * ZP + c0 + SL_SGS);
#pragma unroll
            for (int ai = 0; ai < 2; ++ai)
#pragma unroll
                for (int m = 0; m < 4; ++m) {
                    const int row = u.pm * 256 + ai * 128 + wr * 64 + m * 16 + fr;
                    bf16_t* zr = z6 + (size_t)row * ZP + c0;
                    const u32x4 sg = sgv[ai][m];
                    float v[8];
#pragma unroll
                    for (int n = 0; n < 2; ++n)
#pragma unroll
                        for (int e = 0; e < 4; ++e) {
                            const int j = 4 * n + e; const unsigned sw = sg[j >> 1];
                            const float s = (j & 1) ? bf_hi(sw) : bf_lo(sw);
                            v[j] = s * sigm_f(acc[ai][bj][m][n][e] + (n ? b1[e] : b0[e]));
                        }
                    *(u32x4*)(zr + oslot) = pack8(v);
                }
        }
    }
};

struct Epi3 {
    static constexpr bool AFTER_DRAIN = true;
    int lay; const float* xp; unsigned char* dout; float* rowss_next; unsigned* pctr; const float* gfin;
    DEVI void fused(f32x4 (&acc)[2][2][4][2], const g8::GUnit& u, int wr, int wc, int fr, int fq) const {
        asm volatile("" : "+v"(fr), "+v"(fq));
#pragma unroll
        for (int ai = 0; ai < 2; ++ai)
#pragma unroll
            for (int m = 0; m < 4; ++m) {
                const int row = u.pm * 256 + ai * 128 + wr * 64 + m * 16 + fr;
                float ss = 0.f;
#pragma unroll
                for (int bj = 0; bj < 2; ++bj) {
                    const int c0 = u.pn * 256 + 128 * bj + 32 * wc + 8 * fq;
                    float v[8];
                    if (lay == 0) {
                        const float* xr = xp + (size_t)row * 1024;
                        const f32x4 r0 = *(const f32x4*)(xr + c0), r1 = *(const f32x4*)(xr + c0 + 4);
#pragma unroll
                        for (int e = 0; e < 4; ++e) { v[e] = r0[e] + acc[ai][bj][m][0][e]; v[4 + e] = r1[e] + acc[ai][bj][m][1][e]; }
                        *(u32x4*)(dout + DO_HI + (size_t)row * HL_PITCH + c0 * 2) = pack8(v);
                    } else {
                        const u32x4 hi = *(const u32x4*)(dout + DO_HI + (size_t)row * HL_PITCH + c0 * 2);
#pragma unroll
                        for (int n = 0; n < 2; ++n)
#pragma unroll
                            for (int e = 0; e < 4; ++e) { const int j = 4 * n + e; v[j] = ((j & 1) ? bf_hi(hi[j >> 1]) : bf_lo(hi[j >> 1])) + acc[ai][bj][m][n][e]; }
                        acc[ai][bj][m][0] = (f32x4){v[0], v[1], v[2], v[3]}; acc[ai][bj][m][1] = (f32x4){v[4], v[5], v[6], v[7]};
                    }
#pragma unroll
                    for (int j = 0; j < 8; ++j) ss += v[j] * v[j];
                }
                ss += __shfl_xor(ss, 16); ss += __shfl_xor(ss, 32);
                if (fq == 0) atomicAdd(rowss_next + row, ss);
            }
        if (lay == 0) return;
        asm volatile("s_waitcnt vmcnt(0)" ::: "memory");
        __syncthreads();
        if (threadIdx.x == 0) {
            __hip_atomic_fetch_add(pctr + u.pm, 1u, __ATOMIC_RELAXED, __HIP_MEMORY_SCOPE_AGENT);
            unsigned sp = 0;
            while (__hip_atomic_load(pctr + u.pm, __ATOMIC_RELAXED, __HIP_MEMORY_SCOPE_AGENT) < 4u) { __builtin_amdgcn_s_sleep(2); if (++sp > (1u << 22)) break; }
        }
        __syncthreads();
#pragma unroll
        for (int ai = 0; ai < 2; ++ai)
#pragma unroll
            for (int m = 0; m < 4; ++m) {
                const int row = u.pm * 256 + ai * 128 + wr * 64 + m * 16 + fr;
                const float rs = __builtin_amdgcn_rsqf(__hip_atomic_load(rowss_next + row, __ATOMIC_RELAXED, __HIP_MEMORY_SCOPE_AGENT) * (1.0f / 1024.0f) + EPSF);
#pragma unroll
                for (int bj = 0; bj < 2; ++bj) {
                    const int c0 = u.pn * 256 + 128 * bj + 32 * wc + 8 * fq;
                    const f32x4 g0 = *(const f32x4*)(gfin + c0), g1 = *(const f32x4*)(gfin + c0 + 4);
                    float* yo = (float*)(dout + (size_t)row * 4096) + c0;
                    *(f32x4*)yo = acc[ai][bj][m][0] * rs * g0; *(f32x4*)(yo + 4) = acc[ai][bj][m][1] * rs * g1;
                }
            }
    }
};
struct Epi3s {
    float* slab;
    DEVI void operator()(const f32x4 (&acc)[2][2][4][2], const g8::GUnit& u, int wr, int wc, int fr, int fq) const {
        asm volatile("" : "+v"(fr), "+v"(fq));
        float* sb = slab + (size_t)u.lay * 262144;
#pragma unroll
        for (int ai = 0; ai < 2; ++ai)
#pragma unroll
            for (int m = 0; m < 4; ++m) {
                const int r = ai * 128 + wr * 64 + m * 16 + fr;
#pragma unroll
                for (int bj = 0; bj < 2; ++bj) {
                    float* o = sb + (size_t)r * 1024 + u.pn * 256 + 128 * bj + 32 * wc + 8 * fq;
                    *(f32x4*)o = acc[ai][bj][m][0]; *(f32x4*)(o + 4) = acc[ai][bj][m][1];
                }
            }
    }
};

DEVI void finalize_sample(int r, int l, const P& p, const float* slab, float* rowss_next) {
    const int lane = fresh_tid() & 63, row = MP + r;
    unsigned char* dout = (unsigned char*)p.out;
    float ss = 0.f; f32x4 v[4];
#pragma unroll
    for (int i = 0; i < 4; ++i) {
        const int c = (lane + 64 * i) * 4;
        v[i] = *(const f32x4*)(slab + (size_t)r * 1024 + c);
#pragma unroll
        for (int k = 1; k < 6; ++k) v[i] = v[i] + *(const f32x4*)(slab + (size_t)k * 262144 + (size_t)r * 1024 + c);
        if (l == 0) v[i] = v[i] + *(const f32x4*)(p.in[1] + (size_t)r * 1024 + c);
        else {
            const u32x2 hi = *(const u32x2*)(dout + DO_HI + (size_t)row * HL_PITCH + c * 2), lo = *(const u32x2*)(dout + DO_LO + (size_t)row * HL_PITCH + c * 2);
            v[i] = v[i] + (f32x4){bf_lo(hi.x) + bf_lo(lo.x), bf_hi(hi.x) + bf_hi(lo.x), bf_lo(hi.y) + bf_lo(lo.y), bf_hi(hi.y) + bf_hi(lo.y)};
        }
        ss += v[i][0] * v[i][0] + v[i][1] * v[i][1] + v[i][2] * v[i][2] + v[i][3] * v[i][3];
    }
#pragma unroll
    for (int o = 32; o >= 1; o >>= 1) ss += __shfl_xor(ss, o);
    if (l == 0) {
#pragma unroll
        for (int i = 0; i < 4; ++i) {
            const int c = (lane + 64 * i) * 4;
            u32x2 hi; hi.x = cvt_pk_bf16(v[i][0], v[i][1]); hi.y = cvt_pk_bf16(v[i][2], v[i][3]);
            u32x2 lo; lo.x = cvt_pk_bf16(v[i][0] - bf_lo(hi.x), v[i][1] - bf_hi(hi.x)); lo.y = cvt_pk_bf16(v[i][2] - bf_lo(hi.y), v[i][3] - bf_hi(hi.y));
            *(u32x2*)(dout + DO_HI + (size_t)row * HL_PITCH + c * 2) = hi;
            *(u32x2*)(dout + DO_LO + (size_t)row * HL_PITCH + c * 2) = lo;
        }
        if (lane == 0) rowss_next[row] = ss;
    } else {
        const float rs = __builtin_amdgcn_rsqf(ss * (1.0f / 1024.0f) + EPSF);
#pragma unroll
        for (int i = 0; i < 4; ++i) {
            const int c = (lane + 64 * i) * 4;
            const f32x4 gg = *(const f32x4*)(p.in[25] + c);
            *(f32x4*)(p.out + (size_t)row * 1024 + c) = v[i] * rs * gg;
        }
    }
}

DEVI void group_barrier(unsigned* ctr, unsigned target) {
    __syncthreads();
    if (threadIdx.x == 0) {
        __threadfence();
        __hip_atomic_fetch_add(ctr, 1u, __ATOMIC_RELAXED, __HIP_MEMORY_SCOPE_AGENT);
        while (__hip_atomic_load(ctr, __ATOMIC_RELAXED, __HIP_MEMORY_SCOPE_AGENT) < target) __builtin_amdgcn_s_sleep(4);
        __threadfence();
    }
    __syncthreads();
}

#define XB_TMO      128
#define XB_XCNT(j)  (256  + 64 * (j))
#define XB_XSUB(j)  (1280 + 64 * (j))
#define XB_XGEN(j)  (2304 + 64 * (j))
#define XB_TOP      3328
#define XB_TOPGEN   3392
#define XCD_BAR_WORDS 3456
#define XB_SPIN_CAP (1u << 18)
DEVI unsigned xb_ld(unsigned* p)              { return __hip_atomic_load(p, __ATOMIC_RELAXED, __HIP_MEMORY_SCOPE_AGENT); }
DEVI unsigned xb_add(unsigned* p, unsigned v) { return __hip_atomic_fetch_add(p, v, __ATOMIC_RELAXED, __HIP_MEMORY_SCOPE_AGENT); }
DEVI unsigned xb_xcc_id() { return (unsigned)__builtin_amdgcn_s_getreg((3 << 11) | 20) & 0xFu; }
#define XB_SPIN(cond, bar) do { unsigned _sp = 0; while (cond) { __builtin_amdgcn_s_sleep(1); \
    if ((++_sp & 255u) == 0u) { if (xb_ld(&(bar)[XB_TMO])) break; if (_sp > XB_SPIN_CAP) { atomicAdd(&(bar)[XB_TMO], 1u); break; } } } } while (0)
struct XcdBarrier { unsigned* bar; unsigned x; volatile LAS unsigned* st; };
DEVI XcdBarrier xcd_barrier_post(unsigned* bar, volatile LAS unsigned* st) {
    XcdBarrier b; b.bar = bar; b.x = xb_xcc_id(); b.st = st;
    if (threadIdx.x == 0) (void)xb_add(&bar[XB_XCNT(b.x)], 1u);
    return b;
}
DEVI void xcd_barrier_complete(unsigned* bar, unsigned x, unsigned& nloc, unsigned& nx) {
    const unsigned G = gridDim.x * gridDim.y * gridDim.z;
    unsigned sum, cnt, mine, sp = 0u;
    for (;;) {
        sum = 0u; cnt = 0u; mine = 0u;
#pragma unroll
        for (unsigned j = 0; j < 16; ++j) { const unsigned c = xb_ld(&bar[XB_XCNT(j)]); sum += c; cnt += (c > 0u) ? 1u : 0u; mine = (j == x) ? c : mine; }
        if (sum == G) break;
        __builtin_amdgcn_s_sleep(1);
        if ((++sp & 255u) == 0u) { if (xb_ld(&bar[XB_TMO])) break; if (sp > XB_SPIN_CAP) { atomicAdd(&bar[XB_TMO], 1u); break; } }
    }
    nloc = mine > 0u ? mine : 1u; nx = cnt > 0u ? cnt : 1u;
}
DEVI void xcd_barrier(const XcdBarrier& b) {
    asm volatile("s_waitcnt vmcnt(0)" ::: "memory");
    __syncthreads();
    if (threadIdx.x == 0) {
        unsigned* bar = b.bar;
        __builtin_amdgcn_s_waitcnt(0);
        unsigned nloc = b.st[0], nx = b.st[1];
        if (nloc == 0u) { xcd_barrier_complete(bar, b.x, nloc, nx); b.st[0] = nloc; b.st[1] = nx; }
        const unsigned old = xb_add(&bar[XB_XSUB(b.x)], 1u);
        const unsigned gen = old / nloc;
        if (old + 1u == (gen + 1u) * nloc) {
            __builtin_amdgcn_fence(__ATOMIC_RELEASE, "agent");
            asm volatile("s_waitcnt vmcnt(0)" ::: "memory");
            const unsigned og = xb_add(&bar[XB_TOP], 1u);
            const unsigned tg = og / nx;
            if (og + 1u == (tg + 1u) * nx) xb_add(&bar[XB_TOPGEN], 1u);
            else XB_SPIN(xb_ld(&bar[XB_TOPGEN]) == tg, bar);
            __builtin_amdgcn_fence(__ATOMIC_ACQUIRE, "agent");
            xb_add(&bar[XB_XGEN(b.x)], 1u);
            asm volatile("s_waitcnt vmcnt(0)" ::: "memory");
        } else {
            XB_SPIN(xb_ld(&bar[XB_XGEN(b.x)]) == gen, bar);
            __builtin_amdgcn_fence(__ATOMIC_ACQUIRE, "agent");
            asm volatile("s_waitcnt vmcnt(0)" ::: "memory");
        }
    }
    __syncthreads();
}

DEVI double d_exp(double x) {
    const double kf = __builtin_rint(x * 1.4426950408889634);
    double r = __builtin_fma(-kf, 0.6931471803691238, x); r = __builtin_fma(-kf, 1.9082149292705877e-10, r);
    double p = 1.0 / 6227020800.0;
    p = p * r + 1.0 / 479001600.0; p = p * r + 1.0 / 39916800.0; p = p * r + 1.0 / 3628800.0; p = p * r + 1.0 / 362880.0; p = p * r + 1.0 / 40320.0;
    p = p * r + 1.0 / 5040.0; p = p * r + 1.0 / 720.0; p = p * r + 1.0 / 120.0; p = p * r + 1.0 / 24.0; p = p * r + 1.0 / 6.0; p = p * r + 0.5; p = p * r + 1.0; p = p * r + 1.0;
    const long long k = (long long)kf;
    return p * __longlong_as_double((k + 1023) << 52);
}
DEVI void d_sincos(double th, double& s, double& c) {
    const double q = __builtin_rint(th * 0.6366197723675814);
    double r = __builtin_fma(-q, 1.5707963267948966, th); r = __builtin_fma(-q, 6.123233995736766e-17, r);
    const double r2 = r * r;
    double ps = -1.0 / 121645100408832000.0;
    ps = ps * r2 + 1.0 / 355687428096000.0; ps = ps * r2 - 1.0 / 1307674368000.0; ps = ps * r2 + 1.0 / 6227020800.0; ps = ps * r2 - 1.0 / 39916800.0;
    ps = ps * r2 + 1.0 / 362880.0; ps = ps * r2 - 1.0 / 5040.0; ps = ps * r2 + 1.0 / 120.0; ps = ps * r2 - 1.0 / 6.0; ps = ps * r2 + 1.0;
    const double sr = ps * r;
    double pc = 1.0 / 2432902008176640000.0;
    pc = pc * r2 - 1.0 / 6402373705728000.0; pc = pc * r2 + 1.0 / 20922789888000.0; pc = pc * r2 - 1.0 / 87178291200.0; pc = pc * r2 + 1.0 / 479001600.0;
    pc = pc * r2 - 1.0 / 3628800.0; pc = pc * r2 + 1.0 / 40320.0; pc = pc * r2 - 1.0 / 720.0; pc = pc * r2 + 1.0 / 24.0; pc = pc * r2 - 0.5; pc = pc * r2 + 1.0;
    const int qi = ((int)q) & 3;
    s = (qi == 0) ? sr : (qi == 1) ? pc : (qi == 2) ? -sr : -pc;
    c = (qi == 0) ? pc : (qi == 1) ? -sr : (qi == 2) ? -pc : sr;
}

DEVI void transpose_strip(LAS float* T, const float* src, int ld, int k0, int s0, const float* scale, bf16_t* dst, int ldd, int j0, bool rowperm, bool colperm) {
    const int tid = fresh_tid();
    __syncthreads();
    {
        f32x4 v[8];
#pragma unroll
        for (int i = 0; i < 8; ++i) {
            const int idx = tid + 512 * i, kk = idx >> 4, c4 = idx & 15; int sr = k0 + kk;
            if (rowperm) { const int s5 = sr & 31; sr = (sr & ~31) + 16 * ((s5 >> 2) & 1) + 4 * (s5 >> 3) + (s5 & 3); }
            v[i] = *(const f32x4*)(src + (size_t)sr * ld + s0 + 4 * c4);
            if (scale) { const float sc = scale[k0 + kk]; v[i] = v[i] * sc; }
        }
#pragma unroll
        for (int i = 0; i < 8; ++i) {
            const int idx = tid + 512 * i, kk = idx >> 4, c4 = idx & 15;
#pragma unroll
            for (int e = 0; e < 4; ++e) T[(4 * c4 + e) * 257 + kk] = v[i][e];
        }
    }
    __syncthreads();
    {
        const int k2 = (tid & 31) * 2, jb = tid >> 5;
#pragma unroll
        for (int i = 0; i < 4; ++i) {
            const int jj = jb + 16 * i;
            const int cs = colperm ? (32 * (jj >> 5) + 8 * ((jj >> 2) & 3) + 4 * ((jj >> 4) & 1) + (jj & 3)) : jj;
#pragma unroll
            for (int m = 0; m < 4; ++m)
                *(unsigned*)(dst + (size_t)(j0 + jj) * ldd + k0 + 64 * m + k2) = cvt_pk_bf16(T[cs * 257 + 64 * m + k2], T[cs * 257 + 64 * m + k2 + 1]);
        }
    }
}

DEVI void weight_strip(const P& p, LAS float* T, int l, int idx) {
    unsigned char* dout = (unsigned char*)p.out;
    if (idx < 512) {
        const int jt = idx >> 2, ks = idx & 3, j0 = jt * 64, pn = j0 >> 8, bj = (j0 >> 7) & 1, hh = (j0 >> 6) & 1;
        int s0;
        if (pn < 8) s0 = (bj ? 2 : 0) * 1024 + 128 * pn + 64 * hh;
        else if (pn < 16) s0 = (bj ? 3 : 1) * 1024 + 128 * (pn - 8) + 64 * hh;
        else s0 = (4 + ((pn - 16) >> 2)) * 1024 + 256 * ((pn - 16) & 3) + 128 * bj + 64 * hh;
        bf16_t* dst = (bf16_t*)(l ? p.ws + WS_WT1 : dout + DO_WT1);
        transpose_strip(T, p.in[9] + (size_t)l * 1024 * 8192, 8192, ks * 256, s0, p.in[8] + l * 1024, dst, 1024, j0, false, true);
    } else if (idx < 640) {
        const int x = idx - 512, jt = x >> 2, ks = x & 3;
        bf16_t* dst = (bf16_t*)(l ? p.ws + WS_WT1 : dout + DO_WT1);
        transpose_strip(T, p.in[23] + (size_t)l * 1024 * 2048, 2048, ks * 256, jt * 64, p.in[22] + l * 1024, dst, 1024, 8192 + jt * 64, false, true);
    } else if (idx < 704) {
        const int x = idx - 640, jt = x >> 2, ks = x & 3;
        bf16_t* dst = (bf16_t*)(l ? p.ws + WS_WT2 : dout + DO_WT2);
        transpose_strip(T, p.in[20] + (size_t)l * 1024 * 1024, 1024, ks * 256, jt * 64, nullptr, dst, 1024, jt * 64, false, true);
    } else {
        const int x = idx - 704, jt = x / 12, ks = x % 12;
        bf16_t* dst = (bf16_t*)(p.ws + WS_WT3 + (size_t)l * WT3_STRIDE);
        transpose_strip(T, p.in[24] + (size_t)l * 3072 * 1024, 1024, ks * 256, jt * 64, nullptr, dst, 3072, jt * 64, false, true);
    }
}

DEVI void phase0(const P& p, LAS unsigned char* lds) {
    const int tid = fresh_tid(), G = gridDim.x, bid = blockIdx.x, lane = tid & 63, wid = tid >> 6;
    unsigned char* dout = (unsigned char*)p.out;
    LAS float* T = (LAS float*)lds;
    for (int it = bid; it < 896 + 128; it += G) { if (it < 896) weight_strip(p, T, 0, it); else weight_strip(p, T, 1, 512 + (it - 896)); }
    for (int it = bid; it < 256; it += G) {
        const int l = it >> 7, b = (it >> 4) & 7, h = (it >> 2) & 3, jt = it & 3;
        bf16_t* dst = (bf16_t*)(l ? p.ws + WS_KV : dout + DO_KV) + (size_t)(1 + b) * 524288 + (size_t)h * 131072 + 65536;
        transpose_strip(T, p.in[7] + (size_t)(l * 8 + b) * 256 * 1024, 1024, 0, h * 256 + jt * 64, nullptr, dst, 256, jt * 64, true, false);
    }
    for (int it = bid; it < MROWS_A / 8; it += G) {
        const int row = it * 8 + wid;
        const float* src = row < MP ? p.in[0] + (size_t)row * 1024 : row < MT ? p.in[1] + (size_t)(row - MP) * 1024 : p.in[2] + (size_t)(row - MT) * 1024;
        bf16_t* dst = (bf16_t*)(dout + DO_A1) + (size_t)row * 1024;
        float ss = 0.f; f32x4 vv[4];
#pragma unroll
        for (int i = 0; i < 4; ++i) {
            vv[i] = *(const f32x4*)(src + (lane + 64 * i) * 4);
            ss += vv[i][0] * vv[i][0] + vv[i][1] * vv[i][1] + vv[i][2] * vv[i][2] + vv[i][3] * vv[i][3];
        }
#pragma unroll
        for (int o = 32; o >= 1; o >>= 1) ss += __shfl_xor(ss, o);
        const float rs0 = __builtin_amdgcn_rsqf(ss * (1.0f / 1024.0f) + EPSF);
#pragma unroll
        for (int i = 0; i < 4; ++i) {
            u32x2 w; w.x = cvt_pk_bf16(vv[i][0] * rs0, vv[i][1] * rs0); w.y = cvt_pk_bf16(vv[i][2] * rs0, vv[i][3] * rs0);
            *(u32x2*)(dst + (lane + 64 * i) * 4) = w;
        }
        float* rowss = (float*)(p.ws + WS_ROWSS);
        if (lane == 0) { rowss[row] = ss; rowss[MROWS_A + row] = 0.f; rowss[2 * MROWS_A + row] = 0.f; }
    }
    for (int it = bid; it < 128; it += G) {
        const int l = it >> 6, b = (it >> 3) & 7, kb = it & 7;
        const float* src = p.in[6] + ((size_t)(l * 8 + b) * 256 + kb * 32) * 1024;
        bf16_t* dst = (bf16_t*)(l ? p.ws + WS_KV : dout + DO_KV) + (size_t)(1 + b) * 524288;
#pragma unroll
        for (int i = 0; i < 8; ++i) {
            const int e = (i * 512 + tid) * 8, key = kb * 32 + (e >> 10), c = e & 1023, h = c >> 8, d = c & 255;
            const f32x4 v0 = *(const f32x4*)(src + e), v1 = *(const f32x4*)(src + e + 4);
            u32x4 w; w.x = cvt_pk_bf16(v0[0], v0[1]); w.y = cvt_pk_bf16(v0[2], v0[3]); w.z = cvt_pk_bf16(v1[0], v1[1]); w.w = cvt_pk_bf16(v1[2], v1[3]);
            *(u32x4*)(dst + (size_t)h * 131072 + key * 256 + d) = w;
        }
    }
    for (int it = bid; it < 16; it += G) {
        const int ch = it * 512 + tid, l = ch >> 12, gn = ch & 4095, g = gn >> 6, n = gn & 63;
        unsigned char* par = p.ws + WS_PAR + (size_t)l * PAR_STRIDE;
        const double dt = d_exp((double)p.in[14][l * 64 + g]);
        const double lre = (double)p.in[12][l * 4096 + gn], lim = (double)p.in[13][l * 4096 + gn];
        double s, c; d_sincos(lim * dt, s, c);
        const double mag = d_exp(lre * dt);
        double pr = mag * c, pi = mag * s;
        ((float*)(par + PAR_L1))[gn * 2] = (float)pr; ((float*)(par + PAR_L1))[gn * 2 + 1] = (float)pi;
        const double den = lre * lre + lim * lim, nr = pr - 1.0, ni = pi;
        const double cr = (nr * lre + ni * lim) / den, ci = (ni * lre - nr * lim) / den;
        double qr = pr, qi = pi;
#pragma unroll 1
        for (int k = 0; k < 6; ++k) { const double t = qr * qr - qi * qi; qi = 2.0 * qr * qi; qr = t; }
        ((float*)(par + PAR_L64))[gn * 2] = (float)qr; ((float*)(par + PAR_L64))[gn * 2 + 1] = (float)qi;
#pragma unroll 1
        for (int k = 0; k < 4; ++k) { const double t = qr * qr - qi * qi; qi = 2.0 * qr * qi; qr = t; }
        ((float*)(par + PAR_L1024))[gn * 2] = (float)qr; ((float*)(par + PAR_L1024))[gn * 2 + 1] = (float)qi;
        const float* bre = p.in[15] + ((size_t)l * 4096 + gn) * 16; const float* bim = p.in[16] + ((size_t)l * 4096 + gn) * 16;
        bf16_t* bb = (bf16_t*)(par + PAR_BB);
#pragma unroll
        for (int i = 0; i < 16; i += 2) {
            const double br0 = bre[i], bi0 = bim[i], br1 = bre[i + 1], bi1 = bim[i + 1];
            *(unsigned*)(bb + (g * 128 + n) * 16 + i) = cvt_pk_bf16((float)(cr * br0 - ci * bi0), (float)(cr * br1 - ci * bi1));
            *(unsigned*)(bb + (g * 128 + 64 + n) * 16 + i) = cvt_pk_bf16((float)(cr * bi0 + ci * br0), (float)(cr * bi1 + ci * br1));
        }
    }
    for (int it = bid; it < 256; it += G) {
        const int e = it * 512 + tid, l = e >> 16, r = e & 65535, g = r >> 10, i = (r >> 6) & 15, n = r & 63;
        bf16_t* cm = (bf16_t*)(p.ws + WS_PAR + (size_t)l * PAR_STRIDE + PAR_CM);
        const float cre = p.in[17][(size_t)l * 65536 + r], cim = p.in[18][(size_t)l * 65536 + r];
        *(unsigned*)(cm + (g * 16 + i) * 128 + 2 * n) = cvt_pk_bf16(cre, -cim);
    }
}

DEVI void attn_item(LAS unsigned char* lds, bf16_t* z6, const bf16_t* kvset, int row0, int nvalid, int h, bool dry) {
    const int tid = fresh_tid(), lane = tid & 63, wid = __builtin_amdgcn_readfirstlane(tid >> 6), fr = lane & 15, q4 = lane >> 4;
    const bool active = wid * 16 < nvalid;
    const int row = row0 + wid * 16 + fr;
    __syncthreads();
    {
        const u32x4* src = (const u32x4*)(kvset + (size_t)h * 131072);
#pragma unroll
        for (int i = 0; i < 16; ++i) { const int idx = i * 512 + tid; *(LAS u32x4*)(lds + (idx >> 5) * 544 + (idx & 31) * 16) = src[idx]; }
    }
    bf16x8 qf[8];
    if (active) {
#pragma unroll
        for (int ks = 0; ks < 8; ++ks) qf[ks] = *(const bf16x8*)(z6 + (size_t)row * ZP + SL_Q + h * 256 + 32 * ks + 8 * q4);
    }
    __syncthreads();
    unsigned pk[16][2]; float inv = 0.f;
    f32x4 s[16];
    if (active) {
#pragma unroll
        for (int kt = 0; kt < 16; ++kt) s[kt] = (f32x4){0.f, 0.f, 0.f, 0.f};
#define ATT_LD(dst, st) do { _Pragma("unroll") for (int j = 0; j < 8; ++j) dst[j] = *(const LAS bf16x8*)(lds + (16 * (8 * ((st) & 1) + j) + fr) * 544 + (32 * ((st) >> 1) + 8 * q4) * 2); } while (0)
#define ATT_MM_S(src, st) do { _Pragma("unroll") for (int j = 0; j < 8; ++j) s[8 * ((st) & 1) + j] = __builtin_amdgcn_mfma_f32_16x16x32_bf16(src[j], qf[(st) >> 1], s[8 * ((st) & 1) + j], 0, 0, 0); } while (0)
        bf16x8 fa[8], fb[8];
        ATT_LD(fa, 0);
#pragma unroll
        for (int st = 0; st < 16; st += 2) {
            ATT_LD(fb, st + 1); __builtin_amdgcn_sched_barrier(0);
            ATT_MM_S(fa, st); __builtin_amdgcn_sched_barrier(0);
            if (st + 2 < 16) ATT_LD(fa, st + 2);
            __builtin_amdgcn_sched_barrier(0);
            ATT_MM_S(fb, st + 1); __builtin_amdgcn_sched_barrier(0);
        }
    }
    __builtin_amdgcn_sched_barrier(0);
    u32x4 vreg[16];
    {
        const u32x4* src = (const u32x4*)(kvset + (size_t)h * 131072 + 65536);
#pragma unroll
        for (int i = 0; i < 16; ++i) vreg[i] = src[i * 512 + tid];
    }
    if (active) {
        float mx = -3.0e38f;
#pragma unroll
        for (int kt = 0; kt < 16; ++kt)
#pragma unroll
            for (int r = 0; r < 4; ++r) mx = fmaxf(mx, s[kt][r]);
        mx = fmaxf(mx, __shfl_xor(mx, 16)); mx = fmaxf(mx, __shfl_xor(mx, 32));
        float sum = 0.f;
#pragma unroll
        for (int kt = 0; kt < 16; ++kt) {
            float e0 = __expf(s[kt][0] - mx), e1 = __expf(s[kt][1] - mx), e2 = __expf(s[kt][2] - mx), e3 = __expf(s[kt][3] - mx);
            sum += (e0 + e1) + (e2 + e3);
            pk[kt][0] = cvt_pk_bf16(e0, e1); pk[kt][1] = cvt_pk_bf16(e2, e3);
        }
        sum += __shfl_xor(sum, 16); sum += __shfl_xor(sum, 32);
        inv = 1.0f / sum;
    }
    __syncthreads();
#pragma unroll
    for (int i = 0; i < 16; ++i) { const int idx = i * 512 + tid; *(LAS u32x4*)(lds + (idx >> 5) * 544 + (idx & 31) * 16) = vreg[i]; }
    __syncthreads();
    if (active) {
        f32x4 o[16];
#pragma unroll
        for (int dt = 0; dt < 16; ++dt) o[dt] = (f32x4){0.f, 0.f, 0.f, 0.f};
#define ATT_MM_O(src, st) do { u32x4 pw; pw.x = pk[2 * ((st) >> 1)][0]; pw.y = pk[2 * ((st) >> 1)][1]; pw.z = pk[2 * ((st) >> 1) + 1][0]; pw.w = pk[2 * ((st) >> 1) + 1][1]; const bf16x8 pf = __builtin_bit_cast(bf16x8, pw); \
        _Pragma("unroll") for (int j = 0; j < 8; ++j) o[8 * ((st) & 1) + j] = __builtin_amdgcn_mfma_f32_16x16x32_bf16(src[j], pf, o[8 * ((st) & 1) + j], 0, 0, 0); } while (0)
        bf16x8 fa[8], fb[8];
        ATT_LD(fa, 0);
#pragma unroll
        for (int st = 0; st < 16; st += 2) {
            ATT_LD(fb, st + 1); __builtin_amdgcn_sched_barrier(0);
            ATT_MM_O(fa, st); __builtin_amdgcn_sched_barrier(0);
            if (st + 2 < 16) ATT_LD(fa, st + 2);
            __builtin_amdgcn_sched_barrier(0);
            ATT_MM_O(fb, st + 1); __builtin_amdgcn_sched_barrier(0);
        }
#undef ATT_LD
#undef ATT_MM_S
#undef ATT_MM_O
        bf16_t* zr = z6 + (size_t)row * ZP + h * 256 + 4 * q4;
        u32x2 gqa[16];
#pragma unroll
        for (int dt = 0; dt < 16; ++dt) gqa[dt] = *(const u32x2*)(zr + SL_QGS + 16 * dt);
#pragma unroll
        for (int dt = 0; dt < 16; ++dt) {
            const u32x2 gq = gqa[dt];
            u32x2 w; w.x = cvt_pk_bf16(o[dt][0] * inv * silu_f(bf_lo(gq.x)), o[dt][1] * inv * silu_f(bf_hi(gq.x))); w.y = cvt_pk_bf16(o[dt][2] * inv * silu_f(bf_lo(gq.y)), o[dt][3] * inv * silu_f(bf_hi(gq.y)));
            if (!dry || inv == 12345.678f) *(u32x2*)(zr + SL_Q + 16 * dt) = w;
        }
    }
}

DEVI void conv_item(bf16_t* z6, int rb, int l, const P& p, bool dry) {
    const int tid = fresh_tid(), cg8 = tid & 127, rs = tid >> 7, c0 = cg8 * 8, r0 = rb * 64 + rs * 16;
    const float* cw = p.in[10] + l * 3072; const float* cbias = p.in[11] + l * 1024;
    float w0[8], w1[8], w2[8], bb[8], u1[8], u2[8];
#pragma unroll
    for (int j = 0; j < 8; ++j) { w0[j] = cw[c0 + j]; w1[j] = cw[1024 + c0 + j]; w2[j] = cw[2048 + c0 + j]; bb[j] = cbias[c0 + j]; u1[j] = 0.f; u2[j] = 0.f; }
    const bool seq_start = (r0 < MP) ? (r0 == 0) : (((r0 - MP) & 31) == 0);
    if (!seq_start) {
        const u32x4 a = *(const u32x4*)(z6 + (size_t)(r0 - 2) * ZP + SL_U + c0), b = *(const u32x4*)(z6 + (size_t)(r0 - 1) * ZP + SL_U + c0);
#pragma unroll
        for (int j = 0; j < 8; ++j) { u2[j] = (j & 1) ? bf_hi(a[j >> 1]) : bf_lo(a[j >> 1]); u1[j] = (j & 1) ? bf_hi(b[j >> 1]) : bf_lo(b[j >> 1]); }
    } else if (r0 >= MP) {
        const float* cc = p.in[3] + ((size_t)(l * 8 + ((r0 - MP) >> 5)) * 2) * 1024 + c0;
#pragma unroll
        for (int j = 0; j < 8; ++j) { u2[j] = cc[j]; u1[j] = cc[1024 + j]; }
    }
#pragma unroll 1
    for (int tb = 0; tb < 16; tb += 8) {
    u32x4 uwa[8], gwa[8];
#pragma unroll
    for (int t8 = 0; t8 < 8; ++t8) { const bf16_t* zq = z6 + (size_t)(r0 + tb + t8) * ZP + c0; uwa[t8] = *(const u32x4*)(zq + SL_U); gwa[t8] = *(const u32x4*)(zq + SL_GC); }
#pragma unroll
    for (int t8 = 0; t8 < 8; ++t8) {
        const int row = r0 + tb + t8;
        bf16_t* zr = z6 + (size_t)row * ZP + c0;
        const u32x4 uw = uwa[t8], gw = gwa[t8];
        float v[8], u0[8];
#pragma unroll
        for (int j = 0; j < 8; ++j) {
            u0[j] = (j & 1) ? bf_hi(uw[j >> 1]) : bf_lo(uw[j >> 1]);
            const float g = (j & 1) ? bf_hi(gw[j >> 1]) : bf_lo(gw[j >> 1]);
            v[j] = g * (w0[j] * u2[j] + w1[j] * u1[j] + w2[j] * u0[j] + bb[j]);
            u2[j] = u1[j]; u1[j] = u0[j];
        }
        if (!dry || bb[0] == 12345.678f) *(u32x4*)(zr + SL_GC) = pack8(v);
        int so = -1;
        if (row == MP - 2 || row == MP - 1) so = (int)O_PCONV + (l * 2 + (row - (MP - 2))) * 1024;
        else if (row >= MP && ((row - MP) & 31) >= 30) so = (int)O_SCONV + ((l * 8 + ((row - MP) >> 5)) * 2 + (((row - MP) & 31) - 30)) * 1024;
        if (so >= 0) { float* o = p.out + so + c0; *(f32x4*)o = (f32x4){u0[0], u0[1], u0[2], u0[3]}; *(f32x4*)(o + 4) = (f32x4){u0[4], u0[5], u0[6], u0[7]}; }
    }
    }
}

template <int MODE>
DEVI void ssm_wave_item(LAS unsigned char* img, bf16_t* z6, int wi, int l, const P& p, int oslot = 0) {
    const int lane = fresh_tid() & 63, half = lane >> 5, c31 = lane & 31;
    const int pi = wi >> 6, g = wi & 63;
    const bool samp = pi >= 128;
    const int NS = samp ? 2 : 4;
    int rb0, rb1;
    if (!samp) { rb0 = 128 * pi; rb1 = rb0 + 64; } else { rb0 = MP + 64 * (pi - 128); rb1 = rb0 + 32; }
    const unsigned char* par = p.ws + WS_PAR + (size_t)l * PAR_STRIDE;
    const int rho = c31, hrho = (rho >> 2) & 1, rr = (rho & 3) + 4 * (rho >> 3), kh = half;
    const bf16_t* arow = z6 + (size_t)((hrho ? rb1 : rb0) + rr) * ZP + SL_SU + 16 * g + 8 * kh;
    bf16x8 bbf[4];
#pragma unroll
    for (int nt = 0; nt < 4; ++nt) bbf[nt] = *(const bf16x8*)((const bf16_t*)(par + PAR_BB) + (g * 128 + 32 * nt + c31) * 16 + 8 * kh);
    float lre[2], lim[2], hre[2], him[2];
#pragma unroll
    for (int q = 0; q < 2; ++q) {
        const int n = 32 * q + c31;
        const float* L1 = (const float*)(par + PAR_L1) + (g * 64 + n) * 2; lre[q] = L1[0]; lim[q] = L1[1];
        hre[q] = 0.f; him[q] = 0.f;
    }
    const int myrb = half ? rb1 : rb0;
    bf16x8 cmf[4]; float dv[4];
    if (MODE == 1) {
#pragma unroll
        for (int q = 0; q < 2; ++q) {
            const int n = 32 * q + c31;
            if (!samp) { const float* E = (const float*)(p.ws + WS_E) + (size_t)(2 * pi + half) * 8192 + g * 128; hre[q] = E[n]; him[q] = E[64 + n]; }
            else { const int b = 2 * (pi - 128) + half; hre[q] = p.in[4][((size_t)(l * 8 + b) * 64 + g) * 64 + n]; him[q] = p.in[5][((size_t)(l * 8 + b) * 64 + g) * 64 + n]; }
        }
#pragma unroll
        for (int ks = 0; ks < 4; ++ks) cmf[ks] = *(const bf16x8*)((const bf16_t*)(par + PAR_CM) + (g * 16 + (lane & 15)) * 128 + 32 * ks + 8 * (lane >> 4));
#pragma unroll
        for (int r = 0; r < 4; ++r) dv[r] = p.in[19][l * 1024 + 16 * g + 4 * (lane >> 4) + r];
    }
    bf16x8 afs[4]; u32x2 uws[4][2], sgs[4][2];
#pragma unroll
    for (int s = 0; s < 4; ++s) if (s < NS) {
        afs[s] = *(const bf16x8*)(arow + (size_t)(16 * s) * ZP);
        if (MODE == 1) {
#pragma unroll
            for (int ct = 0; ct < 2; ++ct) {
                const bf16_t* zq = z6 + (size_t)((ct ? rb1 : rb0) + 16 * s + (lane & 15)) * ZP + 16 * g + 4 * (lane >> 4);
                uws[s][ct] = *(const u32x2*)(zq + SL_SU); sgs[s][ct] = *(const u32x2*)(zq + SL_SGS);
            }
        }
    }
#pragma unroll
    for (int s = 0; s < 4; ++s) if (s < NS) {
        const bf16x8 af = afs[s];
        f32x16 d[4];
#pragma unroll
        for (int nt = 0; nt < 4; ++nt) {
            f32x16 z;
#pragma unroll
            for (int r = 0; r < 16; ++r) z[r] = 0.f;
            d[nt] = __builtin_amdgcn_mfma_f32_32x32x16_bf16(af, bbf[nt], z, 0, 0, 0);
        }
#pragma unroll
        for (int r = 0; r < 16; ++r) {
            const float nr0 = __builtin_fmaf(-lim[0], him[0], __builtin_fmaf(lre[0], hre[0], d[0][r]));
            const float ni0 = __builtin_fmaf(lim[0], hre[0], __builtin_fmaf(lre[0], him[0], d[2][r]));
            const float nr1 = __builtin_fmaf(-lim[1], him[1], __builtin_fmaf(lre[1], hre[1], d[1][r]));
            const float ni1 = __builtin_fmaf(lim[1], hre[1], __builtin_fmaf(lre[1], him[1], d[3][r]));
            hre[0] = nr0; him[0] = ni0; hre[1] = nr1; him[1] = ni1;
            if (MODE == 1) {
                *(LAS unsigned*)(img + (half * 16 + r) * 288 + 4 * c31) = cvt_pk_bf16(nr0, ni0);
                *(LAS unsigned*)(img + (half * 16 + r) * 288 + 4 * (32 + c31)) = cvt_pk_bf16(nr1, ni1);
            }
        }
        if (MODE == 1) {
            const int t = lane & 15, q4 = lane >> 4;
#pragma unroll
            for (int ct = 0; ct < 2; ++ct) {
                f32x4 y = (f32x4){0.f, 0.f, 0.f, 0.f};
#pragma unroll
                for (int ks = 0; ks < 4; ++ks) {
                    const bf16x8 hf = *(const LAS bf16x8*)(img + (ct * 16 + t) * 288 + (32 * ks + 8 * q4) * 2);
                    y = __builtin_amdgcn_mfma_f32_16x16x32_bf16(cmf[ks], hf, y, 0, 0, 0);
                }
                bf16_t* zp = z6 + (size_t)((ct ? rb1 : rb0) + 16 * s + t) * ZP + SL_SU + 16 * g + 4 * q4;
                const u32x2 uw = uws[s][ct];
                const u32x2 sw = sgs[s][ct];
                const float y0 = gelu_f(y[0] + dv[0] * bf_lo(uw.x)), y1 = gelu_f(y[1] + dv[1] * bf_hi(uw.x)), y2 = gelu_f(y[2] + dv[2] * bf_lo(uw.y)), y3 = gelu_f(y[3] + dv[3] * bf_hi(uw.y));
                u32x2 w; w.x = cvt_pk_bf16(y0, y1); w.y = cvt_pk_bf16(y2, y3);
                *(u32x2*)(zp + oslot) = w;
                u32x2 wg; wg.x = cvt_pk_bf16(y0 * silu_f(bf_lo(sw.x)), y1 * silu_f(bf_hi(sw.x))); wg.y = cvt_pk_bf16(y2 * silu_f(bf_lo(sw.y)), y3 * silu_f(bf_hi(sw.y)));
                *(u32x2*)(zp + (SL_SGS - SL_SU)) = wg;
            }
        }
    }
    (void)myrb;
    if (MODE == 0) {
        float* E = (float*)(p.ws + WS_E) + (size_t)(2 * pi + half) * 8192 + g * 128;
#pragma unroll
        for (int q = 0; q < 2; ++q) { E[32 * q + c31] = hre[q]; E[64 + 32 * q + c31] = him[q]; }
    } else if (samp) {
        const int b = 2 * (pi - 128) + half;
#pragma unroll
        for (int q = 0; q < 2; ++q) {
            const size_t o = ((size_t)(l * 8 + b) * 64 + g) * 64 + 32 * q + c31;
            p.out[O_SRE + o] = hre[q]; p.out[O_SIM + o] = him[q];
        }
    }
}

DEVI void scan_item(LAS unsigned char* lds, int item, int l, const P& p, bool dry = false) {
    const int tid = fresh_tid(), chl = tid & 31, seg = tid >> 5, ch = item * 32 + chl, g = ch >> 6, n = ch & 63;
    const unsigned char* par = p.ws + WS_PAR + (size_t)l * PAR_STRIDE;
    const float ar = ((const float*)(par + PAR_L64))[ch * 2], ai = ((const float*)(par + PAR_L64))[ch * 2 + 1];
    const float br = ((const float*)(par + PAR_L1024))[ch * 2], bi = ((const float*)(par + PAR_L1024))[ch * 2 + 1];
    float* E = (float*)(p.ws + WS_E) + g * 128 + n;
    float er[16], ei[16];
#pragma unroll
    for (int i = 0; i < 16; ++i) { er[i] = E[(size_t)(seg * 16 + i) * 8192]; ei[i] = E[(size_t)(seg * 16 + i) * 8192 + 64]; }
    float hr = 0.f, hi = 0.f;
#pragma unroll
    for (int i = 0; i < 16; ++i) { const float t = ar * hr - ai * hi + er[i]; hi = ar * hi + ai * hr + ei[i]; hr = t; }
    LAS float* se = (LAS float*)lds;
    __syncthreads();
    se[(seg * 32 + chl) * 2] = hr; se[(seg * 32 + chl) * 2 + 1] = hi;
    __syncthreads();
    hr = 0.f; hi = 0.f;
    for (int s2 = 0; s2 < seg; ++s2) { const float xr = se[(s2 * 32 + chl) * 2], xi = se[(s2 * 32 + chl) * 2 + 1]; const float t = br * hr - bi * hi + xr; hi = br * hi + bi * hr + xi; hr = t; }
#pragma unroll
    for (int i = 0; i < 16; ++i) {
        if (!dry || ar == 12345.678f) { E[(size_t)(seg * 16 + i) * 8192] = hr; E[(size_t)(seg * 16 + i) * 8192 + 64] = hi; }
        const float t = ar * hr - ai * hi + er[i]; hi = ar * hi + ai * hr + ei[i]; hr = t;
    }
    if (seg == 15) { p.out[O_PRE + (size_t)l * 4096 + ch] = hr; p.out[O_PIM + (size_t)l * 4096 + ch] = hi; }
}

__global__ void __launch_bounds__(512, 2) fwd_megakernel(P p) {
    extern __shared__ __attribute__((aligned(16))) unsigned char shm[];
    LAS unsigned char* lds = (LAS unsigned char*)shm;
    cg::grid_group grid = cg::this_grid();
    const int G = gridDim.x, bid = blockIdx.x;
    unsigned char* dout = (unsigned char*)p.out;
    bf16_t* z6 = (bf16_t*)(p.ws + WS_Z6);
    float* rowss = (float*)(p.ws + WS_ROWSS);

    if (threadIdx.x < 4) ((LAS unsigned*)(lds + 139264))[threadIdx.x] = 0u;
    __syncthreads();
    const XcdBarrier xbar = xcd_barrier_post((unsigned*)(p.ws + WS_BAR), (volatile LAS unsigned*)(lds + 139264));
    phase0(p, lds);
    if (p.ws == nullptr) grid.sync();
    xcd_barrier(xbar);
    for (int rep = 0; rep < EXTRA_SYNC; ++rep) xcd_barrier(xbar);

    constexpr int NSB = 48, NPB = 208;
    unsigned* sctr = (unsigned*)(p.ws + WS_CTR);
    float* slab = (float*)(p.ws + WS_SLAB);
    unsigned sep = 0;
#pragma unroll 1
    for (int l = 0; l < 2; ++l) {
        const bf16_t* kvl = (const bf16_t*)(l ? p.ws + WS_KV : dout + DO_KV);
        const char* A1 = (const char*)(dout + (l ? DO_HI : DO_A1));
        const int lda1 = l ? 2048 : 1024;
        const char* W1 = (const char*)(l ? p.ws + WS_WT1 : dout + DO_WT1);
        const char* W2 = (const char*)(l ? p.ws + WS_WT2 : dout + DO_WT2);
        const char* W3 = (const char*)(p.ws + WS_WT3 + (size_t)l * WT3_STRIDE);
        {
            g8::Sched S{}; S.mode = 0; S.nM = 64; S.nN = 32; S.nwg = 64 * 32; S.G = G; S.c = bid; S.nextra = 0;
            S.A = A1; S.B = W1; S.tA = (size_t)256 * lda1 * 2; S.tB = (size_t)256 * 1024 * 2;
            Epi1 E{z6, l ? rowss + MROWS_A : (const float*)nullptr, rowss + MT, p.out, (bf16_t*)(dout + DO_KV), (bf16_t*)(p.ws + WS_KV)};
            g8::gemm_phase<Epi1>(lds, 1024, lda1, 1024, S, E);
        }
        xcd_barrier(xbar);
        const int nsb = l ? 32 : NSB, npb = 256 - nsb;
        if (bid < nsb) {
            if (l == 1) {
                const int widf = __builtin_amdgcn_readfirstlane(fresh_tid() >> 6);
                finalize_sample(bid * 8 + widf, 0, p, slab, rowss + MROWS_A);
                group_barrier(sctr + 2, 32u);
            }
            g8::Sched S{}; S.mode = 1; S.nM = 1; S.nN = 32; S.nwg = 32; S.G = NSB; S.c = bid; S.nextra = (l == 0) ? 16 : 0;
            S.A = A1; S.B = W1; S.tA = (size_t)256 * lda1 * 2; S.tB = (size_t)256 * 1024 * 2;
            S.Ax = (const char*)(dout + DO_A1) + (size_t)65 * 256 * 1024 * 2; S.Bx0 = (const char*)(dout + DO_WT1); S.Bx1 = (const char*)(p.ws + WS_WT1);
            Epi1 E{z6, l ? rowss + MROWS_A : (const float*)nullptr, rowss + MT, p.out, (bf16_t*)(dout + DO_KV), (bf16_t*)(p.ws + WS_KV)};
            g8::gemm_phase<Epi1>(lds, 1024, lda1, 1024, S, E);
        } else {
            const int pb = bid - nsb;
            for (int it = pb; it < 256; it += npb) conv_item(z6, it, l, p, false);
            const int wid = __builtin_amdgcn_readfirstlane(fresh_tid() >> 6);
            for (int it = (pb + npb - (l ? 32 : 48)) % npb; it < 1024; it += npb) ssm_wave_item<0>(lds, z6, it * 8 + wid, l, p);
            if (l == 0) for (int it = pb; it < 352; it += npb) weight_strip(p, (LAS float*)lds, 1, it);
            else if (pb < NPB) attn_item(lds, z6, kvl, (pb >> 2) * 128, 128, pb & 3, false);
        }
        xcd_barrier(xbar);
        if (bid < NSB) {
            for (int it = bid; it < 32; it += NSB) attn_item(lds, z6, kvl + (size_t)(1 + (it >> 2)) * 524288, MP + 32 * (it >> 2), 32, it & 3, false);
            if (bid >= 32 && bid < 36) conv_item(z6, 256 + bid - 32, l, p, false);
            __syncthreads();
            const int wid = __builtin_amdgcn_readfirstlane(fresh_tid() >> 6);
            if (bid >= 32) for (int it = 1024 + (bid - 32); it < 1056; it += 16) ssm_wave_item<1>(lds + wid * 9216, z6, it * 8 + wid, l, p, 0);
        } else {
            for (int rep = 0; rep < REP_SCAN; ++rep) for (int it = bid - NSB; it < 128; it += NPB) scan_item(lds, it, l, p, rep + 1 < REP_SCAN);
            { const int it = (l ? NPB : 0) + bid - NSB; attn_item(lds, z6, kvl, (it >> 2) * 128, 128, it & 3, false); }
            if (l == 0) for (int it = 352 + bid - NSB; it < 768; it += NPB) weight_strip(p, (LAS float*)lds, 1, it < 512 ? it : it + 128);
        }
        xcd_barrier(xbar);
        constexpr int NSD = 20, NPD = 236;
        if (bid < NSD) {
#pragma unroll 1
            for (int batch = 0; batch < 2; ++batch) {
                if (batch == 0) {
                    g8::Sched S{}; S.mode = 2; S.nM = 1; S.nN = 4; S.nwg = 4; S.G = NSB; S.c = bid; S.nextra = 0;
                    S.A = (const char*)(z6 + SL_SU); S.B = W2; S.tA = (size_t)256 * ZP * 2; S.tB = (size_t)256 * 1024 * 2; S.koff = 0; S.kmap = 0u;
                    Epi2 E{z6, p.in[21] + l * 1024, SL_SGS};
                    g8::gemm_phase<Epi2>(lds, 1024, ZP, 1024, S, E);
                }
                {
                    g8::Sched S{}; S.mode = 2; S.nM = 1; S.nN = 4; S.G = NSB; S.nextra = 0;
                    S.nwg = batch ? 8 : 16; S.c = batch ? bid : (bid >= 4 ? bid - 4 : (1 << 20)); S.kmap = batch ? 0x32u : 0x5410u;
                    S.A = (const char*)z6; S.B = W3; S.tA = (size_t)256 * ZP * 2; S.tB = (size_t)256 * 3072 * 2; S.koff = 1024;
                    Epi3s E{slab};
                    g8::gemm_phase<Epi3s>(lds, 512, ZP, 3072, S, E);
                }
                if (batch == 0) group_barrier(sctr + 1, NSD * (unsigned)(l + 1));
            }
        } else {
            const int pb = bid - NSD;
            __syncthreads();
            const int wid = __builtin_amdgcn_readfirstlane(fresh_tid() >> 6);
            const int a0 = l ? 2 * NPB : NPB, nH = l ? 96 : 68;
            const int q = pb;
            if (q < nH) { for (int it = q; it < 3 * nH; it += nH) ssm_wave_item<1>(lds + wid * 9216, z6, it * 8 + wid, l, p, 0); }
            else { for (int it = 3 * nH + (q - nH); it < 1024; it += NPD - nH) ssm_wave_item<1>(lds + wid * 9216, z6, it * 8 + wid, l, p, 0); }
            if (l == 0) { attn_item(lds, z6, kvl, ((a0 + q) >> 2) * 128, 128, (a0 + q) & 3, false); if (q < nH) { const int ia = a0 + NPD + q; attn_item(lds, z6, kvl, (ia >> 2) * 128, 128, ia & 3, false); } }
            else if (q < nH) { const int ia = a0 + q; attn_item(lds, z6, kvl, (ia >> 2) * 128, 128, ia & 3, false); }
        }
        xcd_barrier(xbar);
        {
            g8::Sched S{}; S.mode = 0; S.nM = 64; S.nN = 4; S.nwg = 256; S.G = G; S.c = bid; S.nextra = 0;
            S.A = (const char*)(z6 + SL_SU); S.B = W2; S.tA = (size_t)256 * ZP * 2; S.tB = (size_t)256 * 1024 * 2;
            Epi2 E{z6, p.in[21] + l * 1024, SL_SGS};
            g8::gemm_phase<Epi2>(lds, 1024, ZP, 1024, S, E);
        }
        xcd_barrier(xbar);
        {
            g8::Sched S{}; S.mode = 0; S.nM = 64; S.nN = 4; S.nwg = 256; S.G = G; S.c = bid; S.nextra = 0;
            S.A = (const char*)z6; S.B = W3; S.tA = (size_t)256 * ZP * 2; S.tB = (size_t)256 * 3072 * 2;
            Epi3 E{l, p.in[0], dout, rowss + (l + 1) * MROWS_A, (unsigned*)(p.ws + WS_CTR) + 64, p.in[25]};
            g8::gemm_phase<Epi3>(lds, 3072, ZP, 3072, S, E);
        }
        if (l == 0) xcd_barrier(xbar);
    }
    if (bid < 32) {
        const int widf = __builtin_amdgcn_readfirstlane(fresh_tid() >> 6);
        finalize_sample(bid * 8 + widf, 1, p, slab, rowss);
    }
}

extern "C" void kernel_launch(void* const* d_in, const int* in_sizes, int n_in, void* d_out, int out_size, void* d_ws, size_t ws_size, hipStream_t stream) {
    static int grid_blocks = 0;
    if (!grid_blocks) {
        if (n_in != 26 || ws_size < WS_END || out_size != 18272256) { fprintf(stderr, "kernel_launch: unexpected shapes (n_in %d ws %zu out %d)\n", n_in, ws_size, out_size); grid_blocks = -1; return; }
        int dev = 0, cus = 0, per_cu = 0;
        hipGetDevice(&dev);
        hipDeviceGetAttribute(&cus, hipDeviceAttributeMultiprocessorCount, dev);
        if (hipFuncSetAttribute((const void*)fwd_megakernel, hipFuncAttributeMaxDynamicSharedMemorySize, LDS_BYTES) != hipSuccess) { fprintf(stderr, "kernel_launch: hipFuncSetAttribute failed\n"); grid_blocks = -1; return; }
        hipOccupancyMaxActiveBlocksPerMultiprocessor(&per_cu, (const void*)fwd_megakernel, 512, LDS_BYTES);
        if (per_cu < 1) { fprintf(stderr, "kernel_launch: occupancy query says %d blocks/CU\n", per_cu); per_cu = 1; }
        (void)hipGetLastError();
        if (cus < 256) { fprintf(stderr, "kernel_launch: this kernel's static phase partitions need 256 co-resident blocks (device has %d CUs)\n", cus); grid_blocks = -1; return; }
        grid_blocks = 256;
    }
    if (grid_blocks < 0) return;
    if (hipMemsetAsync((char*)d_ws + WS_CTR, 0, WS_END - WS_CTR, stream) != hipSuccess) { fprintf(stderr, "kernel_launch: hipMemsetAsync failed\n"); return; }
    P p{};
    for (int i = 0; i < 26; ++i) p.in[i] = (const float*)d_in[i];
    p.out = (float*)d_out; p.ws = (unsigned char*)d_ws;
    void* args[] = {&p};
    hipError_t e = hipLaunchCooperativeKernel((void*)fwd_megakernel, dim3(grid_blocks), dim3(512), args, LDS_BYTES, stream);
    if (e != hipSuccess) fprintf(stderr, "cooperative launch failed: %s (grid %d)\n", hipGetErrorString(e), grid_blocks);
}
```
